# Optimizing an MI355X kernel written in HIP

```python
import math
import jax, jax.numpy as jnp
from jax import lax
import numpy as np

D_MODEL = 1024
BATCH = 8
SEQ = 4096
DEPTH = 2

ATT_HEADS = 8
HEAD_DIM = 64
ATT_WIDTH = ATT_HEADS * 2 * HEAD_DIM
Q_BLOCK = 128
ROPE_THETA = 10000.0
MAX_POS_OFFSET = 1024
ML_HEADS = 8
ML_QK_DIM = D_MODEL // 16
ML_V_DIM = D_MODEL // 8
ML_QK = ML_HEADS * ML_QK_DIM
ML_V = ML_HEADS * ML_V_DIM
ML_PROJ = 2 * ML_QK + 2 * ML_V + 2 * ML_HEADS
ML_CHUNK = 64
GATE_SOFTCAP = 15.0
N_EXPERTS = 32
TOP_K = 4
D_FF = D_MODEL
SWIGLU_ALPHA = 1.702
SWIGLU_LIMIT = 7.0
EXPERT_BLOCK = 512
RMS_EPS = 1e-6
N_MIXERS = 2
N_ATT_LAYERS = (DEPTH + 1) // 2
N_ML_LAYERS = DEPTH // 2

kernel_name = 'hybrid_diffattn_mlstm_moe_adaln'


def rms_norm(x, gain):
    xf = x.astype(jnp.float32)
    y = xf * lax.rsqrt(jnp.mean(xf * xf, axis=-1, keepdims=True) + RMS_EPS)
    return (y * gain.astype(jnp.float32)).astype(x.dtype)


def rope_tables(positions):
    inv_freq = ROPE_THETA ** (-jnp.arange(0, HEAD_DIM, 2, dtype=jnp.float32) / HEAD_DIM)
    ang = positions.astype(jnp.float32)[..., None] * inv_freq
    return jnp.cos(ang), jnp.sin(ang)


def apply_rope(x, cos, sin):
    xf = x.astype(jnp.float32)
    x1, x2 = jnp.split(xf, 2, axis=-1)
    return jnp.concatenate([x1 * cos - x2 * sin, x2 * cos + x1 * sin], axis=-1).astype(x.dtype)


def softcap(z):
    return GATE_SOFTCAP * jnp.tanh(z / GATE_SOFTCAP)


def diff_attention(h, cos, sin, w_in, w_out, q_gain, k_gain, lam_q1, lam_k1, lam_q2, lam_k2, sub_gain, lambda_init):
    B, S, _ = h.shape
    f32 = jnp.float32
    nq = S // Q_BLOCK
    q, k, v = jnp.split(h @ w_in, 3, axis=-1)
    q = q.reshape(B, S, ATT_HEADS, 2, HEAD_DIM)
    k = k.reshape(B, S, ATT_HEADS, 2, HEAD_DIM)
    v = v.reshape(B, S, ATT_HEADS, 2 * HEAD_DIM)
    cs, sn = cos[:, :, None, None, :], sin[:, :, None, None, :]
    q = apply_rope(rms_norm(q, q_gain), cs, sn)
    k = apply_rope(rms_norm(k, k_gain), cs, sn)
    lam = (jnp.exp(jnp.sum(lam_q1.astype(f32) * lam_k1.astype(f32)))
           - jnp.exp(jnp.sum(lam_q2.astype(f32) * lam_k2.astype(f32))) + lambda_init)
    q_blocks = q.reshape(B, nq, Q_BLOCK, ATT_HEADS, 2, HEAD_DIM).transpose(1, 0, 3, 4, 2, 5)
    k_t = k.transpose(0, 2, 3, 1, 4)
    v_t = v.transpose(0, 2, 1, 3)
    key_pos = jnp.arange(S)
    scale = HEAD_DIM ** -0.5

    def attend_block(args):
        q_blk, blk = args
        s = jnp.einsum('bhcqd,bhckd->bhcqk', q_blk, k_t).astype(f32) * scale
        q_pos = blk * Q_BLOCK + jnp.arange(Q_BLOCK)
        s = jnp.where(key_pos[None, :] <= q_pos[:, None], s, -jnp.inf)
        p = jax.nn.softmax(s, axis=-1)
        a = p[:, :, 0] - lam * p[:, :, 1]
        return jnp.einsum('bhqk,bhkd->bhqd', a.astype(v_t.dtype), v_t)

    o = lax.map(attend_block, (q_blocks, jnp.arange(nq)))
    o = o.transpose(1, 0, 3, 2, 4).reshape(B, S, ATT_HEADS, 2 * HEAD_DIM)
    o = rms_norm(o, sub_gain) * (1.0 - lambda_init)
    return o.reshape(B, S, ATT_WIDTH) @ w_out


def mlstm_chunkwise(q, k, v, i_pre, log_f):
    f32 = jnp.float32
    B, H, S, dk = q.shape
    dv = v.shape[-1]
    L = ML_CHUNK
    NC = S // L

    def to_chunks(a):
        a = a.astype(f32).reshape(a.shape[:2] + (NC, L) + a.shape[3:])
        return jnp.moveaxis(a, 2, 0)

    xs = tuple(to_chunks(a) for a in (q, k, v, i_pre, log_f))
    causal = jnp.tril(jnp.ones((L, L), dtype=bool))

    def step(carry, inp):
        C, n, m = carry
        qb, kb, vb, ib, fb = inp
        b = jnp.cumsum(fb, axis=-1)
        g = b[..., -1]
        log_d = b[..., :, None] - b[..., None, :] + ib[..., None, :]
        log_d = jnp.where(causal, log_d, -jnp.inf)
        inter = b + m[..., None]
        m_row = jnp.maximum(inter, jnp.max(log_d, axis=-1))
        s = jnp.einsum('bhld,bhsd->bhls', qb, kb) * jnp.exp(log_d - m_row[..., None])
        w_inter = jnp.exp(inter - m_row)
        num = (w_inter[..., None] * jnp.einsum('bhld,bhdv->bhlv', qb, C)
               + jnp.einsum('bhls,bhsv->bhlv', s, vb))
        den = w_inter * jnp.einsum('bhld,bhd->bhl', qb, n) + jnp.sum(s, axis=-1)
        h = num / jnp.maximum(jnp.abs(den), jnp.exp(-m_row))[..., None]
        log_w = g[..., None] - b + ib
        m_new = jnp.maximum(g + m, jnp.max(log_w, axis=-1))
        ws = jnp.exp(log_w - m_new[..., None])
        decay = jnp.exp(g + m - m_new)
        C_new = decay[..., None, None] * C + jnp.einsum('bhl,bhld,bhlv->bhdv', ws, kb, vb)
        n_new = decay[..., None] * n + jnp.einsum('bhl,bhld->bhd', ws, kb)
        return (C_new, n_new, m_new), h

    init = (jnp.zeros((B, H, dk, dv), f32), jnp.zeros((B, H, dk), f32), jnp.zeros((B, H), f32))
    _, hs = lax.scan(step, init, xs)
    return jnp.moveaxis(hs, 0, 2).reshape(B, H, S, dv)


def mlstm_mixer(h, w_in, b_igate, b_fgate, out_gain, w_out):
    B, S, _ = h.shape
    f32 = jnp.float32
    splits = [ML_QK, 2 * ML_QK, 2 * ML_QK + ML_V, 2 * ML_QK + 2 * ML_V, 2 * ML_QK + 2 * ML_V + ML_HEADS]
    q, k, v, o, i_pre, f_pre = jnp.split(h @ w_in, splits, axis=-1)
    q = q.reshape(B, S, ML_HEADS, ML_QK_DIM).transpose(0, 2, 1, 3)
    k = (k * (ML_QK_DIM ** -0.5)).reshape(B, S, ML_HEADS, ML_QK_DIM).transpose(0, 2, 1, 3)
    v = v.reshape(B, S, ML_HEADS, ML_V_DIM).transpose(0, 2, 1, 3)
    i_pre = softcap(i_pre.astype(f32) + b_igate.astype(f32)).transpose(0, 2, 1)
    log_f = jax.nn.log_sigmoid(softcap(f_pre.astype(f32) + b_fgate.astype(f32))).transpose(0, 2, 1)
    ht = mlstm_chunkwise(q, k, v, i_pre, log_f).transpose(0, 2, 1, 3)
    ht = rms_norm(ht, out_gain.reshape(ML_HEADS, ML_V_DIM)).astype(h.dtype)
    y = jax.nn.sigmoid(o).reshape(B, S, ML_HEADS, ML_V_DIM) * ht
    return y.reshape(B, S, ML_V) @ w_out


def moe_ffn(h, w_router, b_router, w_gate_up, b_gate_up, w_down, b_down):
    B, S, D = h.shape
    T = B * S
    G = EXPERT_BLOCK
    xt = h.reshape(T, D)
    logits = (xt @ w_router).astype(jnp.float32) + b_router.astype(jnp.float32)
    top_val, top_idx = lax.top_k(logits, TOP_K)
    gates = jax.nn.softmax(top_val, axis=-1)
    A = T * TOP_K
    flat_e = top_idx.reshape(A).astype(jnp.int32)
    flat_t = (jnp.arange(A, dtype=jnp.int32) // TOP_K)
    flat_w = gates.reshape(A)
    order = jnp.argsort(flat_e)
    se, st, sw = flat_e[order], flat_t[order], flat_w[order]
    counts = jnp.bincount(flat_e, length=N_EXPERTS)
    start = jnp.cumsum(counts) - counts
    padded = (counts + G - 1) // G * G
    pend = jnp.cumsum(padded)
    pstart = pend - padded
    slot = pstart[se] + (jnp.arange(A) - start[se])
    n_blocks = -(-A // G) + N_EXPERTS
    P = n_blocks * G
    slot_tok = jnp.full((P,), T, dtype=jnp.int32).at[slot].set(st)
    slot_w = jnp.zeros((P,), h.dtype).at[slot].set(sw.astype(h.dtype))
    block_e = jnp.minimum(jnp.searchsorted(pend, jnp.arange(n_blocks) * G, side='right'), N_EXPERTS - 1)
    xpad = jnp.concatenate([xt, jnp.zeros((1, D), xt.dtype)], axis=0)

    def expert_block(args):
        idx, e = args
        xb = xpad[idx]
        gu = xb @ w_gate_up[e] + b_gate_up[e]
        glu = jnp.minimum(gu[:, ::2], SWIGLU_LIMIT)
        lin = jnp.clip(gu[:, 1::2], -SWIGLU_LIMIT, SWIGLU_LIMIT)
        act = glu * jax.nn.sigmoid(SWIGLU_ALPHA * glu) * (lin + 1.0)
        return act @ w_down[e] + b_down[e]

    ys = lax.map(expert_block, (slot_tok.reshape(n_blocks, G), block_e)).reshape(P, D)
    out = jax.ops.segment_sum(ys * slot_w[:, None], slot_tok, num_segments=T + 1)[:T]
    return out.reshape(B, S, D)


def setup_inputs(seed: int = 0) -> dict:
    key = jax.random.key(seed)
    ks = jax.random.split(key, 32)
    D = D_MODEL
    f32 = jnp.float32

    def nrm(k, shape, scale):
        return jax.random.normal(k, shape, f32) * scale

    na, nm = N_ATT_LAYERS, N_ML_LAYERS
    positions = (jax.random.randint(ks[2], (BATCH, 1), 0, MAX_POS_OFFSET, dtype=jnp.int32)
                 + jnp.arange(SEQ, dtype=jnp.int32)[None, :])
    return {
        'x': nrm(ks[0], (BATCH, SEQ, D), 1.0),
        'c': nrm(ks[1], (BATCH, D), 1.0),
        'positions': positions,
        'ada_w': nrm(ks[3], (DEPTH, D, 6 * D), 0.5 * D ** -0.5),
        'ada_b': nrm(ks[4], (DEPTH, 6 * D), 0.02),
        'mix_norm': 1.0 + nrm(ks[5], (DEPTH, D), 0.02),
        'ffn_norm': 1.0 + nrm(ks[6], (DEPTH, D), 0.02),
        'att_w_in': nrm(ks[7], (na, D, 3 * ATT_WIDTH), D ** -0.5),
        'att_w_out': nrm(ks[8], (na, ATT_WIDTH, D), ATT_WIDTH ** -0.5),
        'att_q_norm': 1.0 + nrm(ks[9], (na, HEAD_DIM), 0.02),
        'att_k_norm': 1.0 + nrm(ks[10], (na, HEAD_DIM), 0.02),
        'att_lam_q1': nrm(ks[11], (na, HEAD_DIM), 0.1),
        'att_lam_k1': nrm(ks[12], (na, HEAD_DIM), 0.1),
        'att_lam_q2': nrm(ks[13], (na, HEAD_DIM), 0.1),
        'att_lam_k2': nrm(ks[14], (na, HEAD_DIM), 0.1),
        'att_sub_norm': 1.0 + nrm(ks[15], (na, 2 * HEAD_DIM), 0.02),
        'ml_w_in': nrm(ks[16], (nm, D, ML_PROJ), D ** -0.5),
        'ml_b_igate': nrm(ks[17], (nm, ML_HEADS), 0.1),
        'ml_b_fgate': jnp.linspace(3.0, 6.0, ML_HEADS, dtype=f32)[None, :] + nrm(ks[18], (nm, ML_HEADS), 0.1),
        'ml_out_norm': 1.0 + nrm(ks[19], (nm, ML_V), 0.02),
        'ml_w_out': nrm(ks[20], (nm, ML_V, D), ML_V ** -0.5),
        'router_w': nrm(ks[21], (DEPTH, D, N_EXPERTS), D ** -0.5),
        'router_b': nrm(ks[22], (DEPTH, N_EXPERTS), 0.01),
        'moe_w_gate_up': nrm(ks[23], (DEPTH, N_EXPERTS, D, 2 * D_FF), D ** -0.5),
        'moe_b_gate_up': nrm(ks[24], (DEPTH, N_EXPERTS, 2 * D_FF), 0.02),
        'moe_w_down': nrm(ks[25], (DEPTH, N_EXPERTS, D_FF, D), D_FF ** -0.5),
        'moe_b_down': nrm(ks[26], (DEPTH, N_EXPERTS, D), 0.02),
    }


def reference(x, c, positions, ada_w, ada_b, mix_norm, ffn_norm,
              att_w_in, att_w_out, att_q_norm, att_k_norm, att_lam_q1, att_lam_k1, att_lam_q2, att_lam_k2, att_sub_norm,
              ml_w_in, ml_b_igate, ml_b_fgate, ml_out_norm, ml_w_out,
              router_w, router_b, moe_w_gate_up, moe_b_gate_up, moe_w_down, moe_b_down):
    cos, sin = rope_tables(positions)
    c_act = jax.nn.silu(c)
    for layer in range(DEPTH):
        mod = (c_act @ ada_w[layer] + ada_b[layer])[:, None, :]
        sh1, sc1, g1, sh2, sc2, g2 = jnp.split(mod, 6, axis=-1)
        h = rms_norm(x, mix_norm[layer]) * (1.0 + sc1) + sh1
        j = layer // N_MIXERS
        if layer % N_MIXERS == 0:
            lambda_init = 0.8 - 0.6 * math.exp(-0.3 * layer)
            y = diff_attention(h, cos, sin, att_w_in[j], att_w_out[j], att_q_norm[j], att_k_norm[j],
                               att_lam_q1[j], att_lam_k1[j], att_lam_q2[j], att_lam_k2[j], att_sub_norm[j], lambda_init)
        else:
            y = mlstm_mixer(h, ml_w_in[j], ml_b_igate[j], ml_b_fgate[j], ml_out_norm[j], ml_w_out[j])
        x = x + g1 * y
        h = rms_norm(x, ffn_norm[layer]) * (1.0 + sc2) + sh2
        x = x + g2 * moe_ffn(h, router_w[layer], router_b[layer], moe_w_gate_up[layer],
                             moe_b_gate_up[layer], moe_w_down[layer], moe_b_down[layer])
    return x
```

```cpp
#include <hip/hip_runtime.h>
#include <hip/hip_bf16.h>
#include <cstdio>
#include <cstdint>
#include <cmath>

constexpr int NB = 8, SEQ = 4096, T = NB * SEQ, DM = 1024;
constexpr int NEXP = 32, TOPK = 4, NASG = T * TOPK;
constexpr int MAXMT = NASG / 256 + NEXP;
constexpr int MLN = 3328;
constexpr float RMS_EPS = 1e-6f;
constexpr float C2Q = 0.125f * 1.4426950408889634f;
constexpr float WSCALE = 32.0f, WSCALE_INV = 1.0f / 32.0f;

#define GAS __attribute__((address_space(1)))
#define LAS __attribute__((address_space(3)))
typedef unsigned short bf16;
typedef unsigned v4u __attribute__((ext_vector_type(4)));
typedef unsigned v2u __attribute__((ext_vector_type(2)));
typedef float f32x4 __attribute__((ext_vector_type(4)));
typedef float f32x16 __attribute__((ext_vector_type(16)));
typedef short bf16x8 __attribute__((ext_vector_type(8)));
#define RLX_AGENT __ATOMIC_RELAXED, __HIP_MEMORY_SCOPE_AGENT
#define LDS_WAIT() asm volatile("s_waitcnt lgkmcnt(0)" ::: "memory")
#define VM_WAIT() asm volatile("s_waitcnt vmcnt(0)" ::: "memory")

typedef float f32x2_c __attribute__((ext_vector_type(2))); typedef __bf16 bf16x2_c __attribute__((ext_vector_type(2)));
__device__ __forceinline__ unsigned cvt_pk_bf16(float lo, float hi) { const f32x2_c v = {lo, hi}; const bf16x2_c b = __builtin_convertvector(v, bf16x2_c); return __builtin_bit_cast(unsigned, b); }
__device__ __forceinline__ v2u pack8_fp8(const float (&x)[8]) {
    float c[8];
#pragma unroll
    for (int j = 0; j < 8; ++j) c[j] = x[j];
    int w0 = 0, w1 = 0;
    w0 = __builtin_amdgcn_cvt_pk_fp8_f32(c[0], c[1], w0, false); w0 = __builtin_amdgcn_cvt_pk_fp8_f32(c[2], c[3], w0, true);
    w1 = __builtin_amdgcn_cvt_pk_fp8_f32(c[4], c[5], w1, false); w1 = __builtin_amdgcn_cvt_pk_fp8_f32(c[6], c[7], w1, true);
    v2u r; r.x = (unsigned)w0; r.y = (unsigned)w1; return r;
}
__device__ __forceinline__ float bf_lo(unsigned w) { return __uint_as_float(w << 16); }
__device__ __forceinline__ float bf_hi(unsigned w) { return __uint_as_float(w & 0xffff0000u); }
template <int CTRL, int ROW_MASK> __device__ __forceinline__ float dppf(float v) { return __int_as_float(__builtin_amdgcn_update_dpp(0, __float_as_int(v), CTRL, ROW_MASK, 0xf, true)); }
__device__ __forceinline__ float sum_lanes8(float v) { v += dppf<0xB1, 0xf>(v); v += dppf<0x4E, 0xf>(v); v += dppf<0x141, 0xf>(v); return v; }
__device__ __forceinline__ float sum_lanes16(float v) { v = sum_lanes8(v); v += dppf<0x140, 0xf>(v); return v; }
__device__ __forceinline__ float wave_sum(float v) {
    v = sum_lanes16(v);
    { const unsigned u = __float_as_uint(v); auto r = __builtin_amdgcn_permlane16_swap(u, u, false, false); v = __uint_as_float(r[0]) + __uint_as_float(r[1]); }
    { const unsigned u = __float_as_uint(v); auto r = __builtin_amdgcn_permlane32_swap(u, u, false, false); v = __uint_as_float(r[0]) + __uint_as_float(r[1]); }
    return v;
}
__device__ __forceinline__ float sum_fq4(float v) {
    { const unsigned u = __float_as_uint(v); auto r = __builtin_amdgcn_permlane16_swap(u, u, false, false); v = __uint_as_float(r[0]) + __uint_as_float(r[1]); }
    { const unsigned u = __float_as_uint(v); auto r = __builtin_amdgcn_permlane32_swap(u, u, false, false); v = __uint_as_float(r[0]) + __uint_as_float(r[1]); }
    return v;
}
__device__ __forceinline__ float sigmoidf_(float z) { return __builtin_amdgcn_rcpf(1.0f + __builtin_amdgcn_exp2f(-1.4426950408889634f * z)); }

namespace pg8 {
#define PG8_LAS __attribute__((address_space(3)))
typedef unsigned short bf16_t;
typedef short bf16x8 __attribute__((ext_vector_type(8)));
typedef float f32x4 __attribute__((ext_vector_type(4)));
typedef unsigned u32x4 __attribute__((ext_vector_type(4)));
typedef int v4i_t __attribute__((ext_vector_type(4)));
constexpr int BM = 256, BK = 64, HALF = 128, HTB = HALF * BK * 2, STAGE_BYTES = 8 * HTB, NXCD = 8, WGM = 8;
constexpr int KD = 1024;

__host__ __device__ __forceinline__ int lds_byte(int r, int c) { const int st = (r >> 4) * 2 + (c >> 5), rr = r & 15, cc = c & 31, ob = rr * 64 + cc * 2; return st * 1024 + (ob ^ (((ob >> 9) & 1) << 5)); }
__host__ __device__ __forceinline__ void stage_rc(int b, int& R, int& C) { const int st = b / 1024, sb = b % 1024, swz = sb ^ (((sb >> 9) & 1) << 5); R = (st >> 1) * 16 + swz / 64; C = (st & 1) * 32 + (swz % 64) / 2; }
__host__ __device__ __forceinline__ int perm32(int rho) { const int n = rho >> 4, i = rho & 15; return 8 * (i >> 2) + 4 * n + (i & 3); }

struct Unit { int pm, pn, e; };
struct EpiPre { f32x4 v[4]; };

struct DenseSched {
    static constexpr bool GATHER = false;
    int nM, nN, nwg, G, c;
    __device__ void init(int M, int N, int G_, int c_) { nM = M / BM; nN = N / BM; nwg = nM * nN; G = G_; c = c_; }
    __device__ __forceinline__ bool next(int i, Unit& u) const {
        const long L = (long)i * G + c; if (L >= nwg) return false;
        int wgid = (int)L; { const int q = nwg / NXCD, r = nwg % NXCD, xcd = wgid % NXCD, off = wgid / NXCD; wgid = (xcd < r ? xcd * (q + 1) : r * (q + 1) + (xcd - r) * q) + off; }
        const int nig = WGM * nN, gid = wgid / nig, fm = gid * WGM, gsz = (nM - fm) < WGM ? (nM - fm) : WGM;
        u.pm = fm + ((wgid % nig) % gsz); u.pn = (wgid % nig) / gsz; u.e = 0; return true;
    }
    __device__ __forceinline__ unsigned a_row(const Unit& u, int r) const { return (unsigned)(u.pm * BM + r); }
    __device__ __forceinline__ unsigned b_row0(const Unit& u) const { return (unsigned)(u.pn * BM); }
};

template <class Epi, class Sched, bool ALIGN_EPI, bool F8 = false, int PROBE = 0>
__device__ __forceinline__ void gemm_phase(PG8_LAS unsigned char* lds, const bf16_t* A, const bf16_t* Bt, const Sched& S, const Epi& E) {
    int tid_ = threadIdx.x; asm volatile("" : "+v"(tid_));
    const int tid = tid_, wid = __builtin_amdgcn_readfirstlane(tid >> 6), lane = tid & 63, wr = wid >> 2, wc = wid & 3, fr = lane & 15, fq = lane >> 4;
    constexpr int K = F8 ? KD / 2 : KD, nt = K / BK;
    int Rr[2], Cc[2];
#pragma unroll
    for (int i = 0; i < 2; ++i) { int R, C; stage_rc(tid * 16 + i * 8192, R, C); Rr[i] = R; Cc[i] = C; }
    const unsigned cpart = (unsigned)(((lane & 3) * 8) ^ ((lane >> 5) * 16));
    const unsigned laneA = ((unsigned)(lane >> 2) * (unsigned)K + cpart) * 2u, laneB = ((unsigned)(8 * (lane >> 4) + ((lane >> 2) & 3)) * (unsigned)K + cpart) * 2u;
    constexpr size_t kstep = (size_t)(BK * 2);
    const unsigned ldsw = (unsigned)wid * 1024u;
    const int aoff = lds_byte(wr * 64 + fr, fq * 8), boff = lds_byte(wc * 32 + fr, fq * 8);
#define PG8_SA(b, h) (((b) * 2 + (h)) * HTB)
#define PG8_SB(b, h) ((4 + (b) * 2 + (h)) * HTB)
#define PG8_SOFF_A(_i, hh) ((size_t)(((((wid + 8 * (_i)) >> 1) * 16 + (hh) * HALF) * K + ((wid + 8 * (_i)) & 1) * 32) * 2))
#define PG8_SOFF_B(_i, hh) ((size_t)(((((wid + 8 * (_i)) >> 2) * 32 + 4 * (((wid + 8 * (_i)) >> 1) & 1) + (hh) * HALF) * K + ((wid + 8 * (_i)) & 1) * 32) * 2))
#define PG8_DMA(bufoff, _i, sptr, lanev) do { if constexpr ((PROBE & 2) != 0) break; const char* sp_ = (sptr); asm volatile("" : "+s"(sp_)); unsigned vo_ = (lanev); asm volatile("" : "+v"(vo_)); \
        __builtin_amdgcn_global_load_lds((const unsigned*)(sp_ + (size_t)vo_), (PG8_LAS unsigned*)(lds + (bufoff) + ldsw + (_i) * 8192), 16, 0, 0); } while (0)
#define PG8_STAGE_B(bufoff, hh, sbyte) do { _Pragma("unroll") for (int _i = 0; _i < 2; ++_i) PG8_DMA(bufoff, _i, Bb + (size_t)(sbyte) + PG8_SOFF_B(_i, hh), laneB); } while (0)
#define PG8_STAGE_AC(bufoff, hh, sbyte) do { _Pragma("unroll") for (int _i = 0; _i < 2; ++_i) PG8_DMA(bufoff, _i, Ab + (size_t)(sbyte) + PG8_SOFF_A(_i, hh), laneA); } while (0)
#define PG8_STAGE_AX(bufoff, offs, kbyte) do { _Pragma("unroll") for (int _i = 0; _i < 2; ++_i) PG8_DMA(bufoff, _i, Ab + (size_t)(kbyte), (offs)[_i]); } while (0)
#define PG8_STA_CUR(bufoff, hh, kb) do { if constexpr (GATHER) { PG8_STAGE_AX(bufoff, aoc[hh], kb); } else { PG8_STAGE_AC(bufoff, hh, cA + (size_t)(kb)); } } while (0)
#define PG8_STA_NXT(bufoff, hh, ex) do { if constexpr (GATHER) { PG8_STAGE_AX(bufoff, o2[hh], kb2 + (size_t)(ex)); } else { PG8_STAGE_AC(bufoff, hh, a2s + (size_t)(ex)); } } while (0)
#define PG8_LDA(dst, b, h) do { _Pragma("unroll") for (int m = 0; m < 4; ++m) _Pragma("unroll") for (int k = 0; k < 2; ++k) dst[m][k] = *(const PG8_LAS bf16x8*)(lds + PG8_SA(b, h) + aoff + m * 2048 + k * 1024); } while (0)
#define PG8_LDB(dst, b, h) do { _Pragma("unroll") for (int n = 0; n < 2; ++n) _Pragma("unroll") for (int k = 0; k < 2; ++k) dst[n][k] = *(const PG8_LAS bf16x8*)(lds + PG8_SB(b, h) + boff + n * 2048 + k * 1024); } while (0)
#define PG8_MMA(ai, bj, At, Bt_) do { if constexpr ((PROBE & 1) != 0) break; __builtin_amdgcn_s_setprio(1); _Pragma("unroll") for (int m = 0; m < 4; ++m) _Pragma("unroll") for (int n = 0; n < 2; ++n) { \
        if constexpr (F8) { const v4i_t b0_ = __builtin_bit_cast(v4i_t, Bt_[n][0]), b1_ = __builtin_bit_cast(v4i_t, Bt_[n][1]), a0_ = __builtin_bit_cast(v4i_t, At[m][0]), a1_ = __builtin_bit_cast(v4i_t, At[m][1]); \
            acc[ai][bj][m][n] = __builtin_amdgcn_mfma_scale_f32_16x16x128_f8f6f4(__builtin_shufflevector(b0_, b1_, 0, 1, 2, 3, 4, 5, 6, 7), __builtin_shufflevector(a0_, a1_, 0, 1, 2, 3, 4, 5, 6, 7), acc[ai][bj][m][n], 0, 0, 0, 0x7f7f7f7f, 0, 0x7f7f7f7f); } \
        else { _Pragma("unroll") for (int k = 0; k < 2; ++k) acc[ai][bj][m][n] = __builtin_amdgcn_mfma_f32_16x16x32_bf16(Bt_[n][k], At[m][k], acc[ai][bj][m][n], 0, 0, 0); } } \
        __builtin_amdgcn_s_setprio(0); } while (0)
#define PG8_WAIT_V(n) asm volatile("s_waitcnt vmcnt(" #n ")" ::: "memory")
#define PG8_WAIT_L(n) asm volatile("s_waitcnt lgkmcnt(" #n ")" ::: "memory")
#define PG8_BAR __builtin_amdgcn_s_barrier()
#define PG8_SCHED __builtin_amdgcn_sched_barrier(0)
    Unit cur, nxt; int ui = 0;
    if (!S.next(0, cur)) return;
    EpiPre pre; E.prefetch(pre, cur, wr, wc, fr, fq);
    f32x4 acc[2][2][4][2];
#pragma unroll
    for (int a = 0; a < 2; ++a)
#pragma unroll
        for (int b = 0; b < 2; ++b)
#pragma unroll
            for (int m = 0; m < 4; ++m)
#pragma unroll
                for (int n = 0; n < 2; ++n) acc[a][b][m][n] = (f32x4){0.f, 0.f, 0.f, 0.f};
    bf16x8 At[4][2], B0[2][2], B1[2][2];
    const char* Ab = (const char*)A;
    constexpr bool GATHER = Sched::GATHER;
    unsigned aoc[2][2], aon[2][2]; size_t cA = 0, nA = 0;
#pragma unroll
    for (int h = 0; h < 2; ++h)
#pragma unroll
        for (int i = 0; i < 2; ++i) { aoc[h][i] = 0u; aon[h][i] = 0u;
            if constexpr (GATHER) aoc[h][i] = (S.a_row(cur, h * HALF + Rr[i]) * (unsigned)K + (unsigned)Cc[i]) * 2u; }
    if constexpr (!GATHER) cA = (size_t)S.a_row(cur, 0) * (size_t)(K * 2);
    const char* Bb = (const char*)Bt; size_t cB = (size_t)S.b_row0(cur) * (size_t)(K * 2);
    PG8_STAGE_B(PG8_SB(0, 0), 0, cB); PG8_STAGE_B(PG8_SB(0, 1), 1, cB); PG8_STA_CUR(PG8_SA(0, 0), 0, 0); PG8_STA_CUR(PG8_SA(0, 1), 1, 0);
    if (wr == 1) PG8_BAR;
    PG8_WAIT_V(2); PG8_BAR;
    PG8_STAGE_B(PG8_SB(1, 0), 0, cB + kstep); PG8_STA_CUR(PG8_SA(1, 0), 0, kstep); PG8_STAGE_B(PG8_SB(1, 1), 1, cB + kstep);
    PG8_WAIT_V(6); PG8_BAR;
    for (;;) {
        const bool has_next = S.next(ui + 1, nxt);
        size_t nB = cB;
        nA = cA;
        if (has_next) {
            if constexpr (GATHER) {
#pragma unroll
                for (int h = 0; h < 2; ++h)
#pragma unroll
                    for (int i = 0; i < 2; ++i) aon[h][i] = (S.a_row(nxt, h * HALF + Rr[i]) * (unsigned)K + (unsigned)Cc[i]) * 2u;
            } else nA = (size_t)S.a_row(nxt, 0) * (size_t)(K * 2);
            nB = (size_t)S.b_row0(nxt) * (size_t)(K * 2);
        } else {
#pragma unroll
            for (int h = 0; h < 2; ++h)
#pragma unroll
                for (int i = 0; i < 2; ++i) aon[h][i] = aoc[h][i];
        }
#pragma nounroll
        for (int t = 0; t < nt; t += 2) {
            const bool last = (t == nt - 2);
            const size_t kb1 = (size_t)(t + 1) * kstep;
            const size_t kb2 = last ? (size_t)0 : (size_t)(t + 2) * kstep;
            unsigned o2[2][2];
#pragma unroll
            for (int h = 0; h < 2; ++h)
#pragma unroll
                for (int i = 0; i < 2; ++i) o2[h][i] = last ? aon[h][i] : aoc[h][i];
            const size_t a2s = last ? nA : cA + (size_t)(t + 2) * kstep; (void)a2s;
            const size_t b2 = last ? nB : cB + (size_t)(t + 2) * kstep;
            const size_t b3 = b2 + kstep;
            PG8_LDB(B0, 0, 0); PG8_LDB(B1, 0, 1); PG8_SCHED; PG8_LDA(At, 0, 0); PG8_STA_CUR(PG8_SA(1, 1), 1, kb1);
            PG8_WAIT_V(8); PG8_WAIT_L(0); PG8_BAR; PG8_MMA(0, 0, At, B0); PG8_MMA(0, 1, At, B1); PG8_BAR; PG8_SCHED;
            PG8_LDA(At, 0, 1); PG8_STAGE_B(PG8_SB(0, 0), 0, b2); PG8_STAGE_B(PG8_SB(0, 1), 1, b2); PG8_STA_NXT(PG8_SA(0, 0), 0, 0);
            PG8_WAIT_V(8); PG8_WAIT_L(0); PG8_BAR; PG8_MMA(1, 0, At, B0); PG8_MMA(1, 1, At, B1); PG8_BAR; PG8_SCHED;
            PG8_LDB(B0, 1, 0); PG8_LDB(B1, 1, 1); PG8_SCHED; PG8_LDA(At, 1, 0); PG8_STA_NXT(PG8_SA(0, 1), 1, 0);
            PG8_WAIT_V(8); PG8_WAIT_L(0); PG8_BAR; PG8_MMA(0, 0, At, B0); PG8_MMA(0, 1, At, B1); PG8_BAR; PG8_SCHED;
            PG8_LDA(At, 1, 1); PG8_STAGE_B(PG8_SB(1, 0), 0, b3); PG8_STAGE_B(PG8_SB(1, 1), 1, b3); PG8_STA_NXT(PG8_SA(1, 0), 0, kstep);
            PG8_WAIT_V(8); PG8_WAIT_L(0); PG8_BAR; PG8_MMA(1, 0, At, B0); PG8_MMA(1, 1, At, B1); PG8_BAR; PG8_SCHED;
        }
        if constexpr (ALIGN_EPI) { if (wr == 0) PG8_BAR; }
        E(acc, cur, wr, wc, fr, fq, pre);
        if (!has_next) break;
#pragma unroll
        for (int a = 0; a < 2; ++a)
#pragma unroll
            for (int b = 0; b < 2; ++b)
#pragma unroll
                for (int m = 0; m < 4; ++m)
#pragma unroll
                    for (int n = 0; n < 2; ++n) acc[a][b][m][n] = (f32x4){0.f, 0.f, 0.f, 0.f};
        cur = nxt; cB = nB; cA = nA; ++ui;
        E.prefetch(pre, cur, wr, wc, fr, fq);
#pragma unroll
        for (int h = 0; h < 2; ++h)
#pragma unroll
            for (int i = 0; i < 2; ++i) aoc[h][i] = aon[h][i];
        if constexpr (ALIGN_EPI) { if (wr == 1) PG8_BAR; }
    }
    PG8_WAIT_V(0);
    if constexpr (!ALIGN_EPI) { if (wr == 0) PG8_BAR; }
    PG8_BAR;
#undef PG8_SA
#undef PG8_SB
#undef PG8_STAGE_AX
#undef PG8_STA_CUR
#undef PG8_STA_NXT
#undef PG8_STAGE_B
#undef PG8_STAGE_AC
#undef PG8_DMA
#undef PG8_SOFF_A
#undef PG8_SOFF_B
#undef PG8_LDA
#undef PG8_LDB
#undef PG8_MMA
#undef PG8_WAIT_V
#undef PG8_WAIT_L
#undef PG8_BAR
#undef PG8_SCHED
}
}

namespace attn_body {
using bf16h=__hip_bfloat16;
using bf16x8=__attribute__((ext_vector_type(8)))short;
using s16x4=__attribute__((ext_vector_type(4)))short;
using f32x16=__attribute__((ext_vector_type(16)))float;
using u32x4=__attribute__((ext_vector_type(4)))unsigned;
constexpr int D=64,PITCH=1024,OPITCH=2048;
constexpr int NW=8,QBLK=32,QB=QBLK*NW,KVBLK=64;
__device__ __forceinline__ int crow(int r,int hi){return (r&3)+8*(r>>2)+4*hi;}
#define SBAR() __builtin_amdgcn_sched_barrier(0)
__device__ __forceinline__ void cmask(f32x16&p0,f32x16&p1,int jb,int qrel,int hi){
  const float NEG=-INFINITY; int kb=64*jb+4*hi;
  #pragma unroll
  for(int r=0;r<16;++r){int kv=kb+(r&3)+8*(r>>2); if(kv>qrel)p0[r]=NEG; if(kv+32>qrel)p1[r]=NEG;}
}
constexpr int NSLOT=3, SLOTB=8192;
constexpr int LDS_K=0, LDS_V=NSLOT*SLOTB, LDS_WS=2*NSLOT*SLOTB, LDS_OST=LDS_WS+NW*64*4, LDS_BYTES=LDS_OST+NW*4096;
__device__ __forceinline__ void glds16(const void*gsrc,unsigned lds_dst){unsigned keep;
  asm volatile("s_mov_b32 %0, m0\n\ts_mov_b32 m0, %2\n\ts_nop 0\n\tglobal_load_lds_dwordx4 %1, off\n\ts_mov_b32 m0, %0":"=&s"(keep):"v"(gsrc),"s"(lds_dst):"memory");}
__device__ __forceinline__ float max3f(float a,float b,float c){float r;asm("v_max3_f32 %0, %1, %2, %3":"=v"(r):"v"(a),"v"(b),"v"(c));return r;}
__device__ __forceinline__ float max2f(float a,float b){float r;asm("v_max_f32_e32 %0, %1, %2":"=v"(r):"v"(a),"v"(b));return r;}
__device__ __forceinline__ float fadd_s(float a,float b){float r;asm("v_add_f32_e32 %0, %1, %2":"=v"(r):"v"(a),"v"(b));return r;}
__device__ __forceinline__ float fsub_s(float a,float b){float r;asm("v_sub_f32_e32 %0, %1, %2":"=v"(r):"v"(a),"v"(b));return r;}
typedef float f32x2_t __attribute__((ext_vector_type(2))); typedef __bf16 bf16x2_t __attribute__((ext_vector_type(2)));
__device__ __forceinline__ unsigned cvtpk_s(float lo,float hi){f32x2_t v={lo,hi};bf16x2_t b=__builtin_convertvector(v,bf16x2_t);return __builtin_bit_cast(unsigned,b);}
#define WAIT_BAR(N) asm volatile("s_waitcnt vmcnt(" #N ") lgkmcnt(0)\n\ts_barrier":::"memory")
__device__ __forceinline__ void qkt(f32x16&p0,f32x16&p1,const char*Kslot,const bf16x8*qr,const f32x16&negm,int r32,int hi){
  const char*kb=Kslot+hi*1024+r32*16;
  #pragma unroll
  for(int d0=0;d0<4;++d0){
    const bf16x8 b0=*reinterpret_cast<const bf16x8*>(kb+d0*2048);
    const bf16x8 b1=*reinterpret_cast<const bf16x8*>(kb+d0*2048+512);
    if(d0==0){p0=__builtin_amdgcn_mfma_f32_32x32x16_bf16(b0,qr[0],negm,0,0,0);p1=__builtin_amdgcn_mfma_f32_32x32x16_bf16(b1,qr[0],negm,0,0,0);}
    else{p0=__builtin_amdgcn_mfma_f32_32x32x16_bf16(b0,qr[d0],p0,0,0,0);p1=__builtin_amdgcn_mfma_f32_32x32x16_bf16(b1,qr[d0],p1,0,0,0);}}
}
typedef __attribute__((address_space(3))) const char* lds_cptr;
typedef short v4i16_t __attribute__((ext_vector_type(4)));
__device__ __forceinline__ void kload8(bf16x8*kf,lds_cptr kp){
  kf[0]=*(const __attribute__((address_space(3))) bf16x8*)(kp);      kf[1]=*(const __attribute__((address_space(3))) bf16x8*)(kp+512);
  kf[2]=*(const __attribute__((address_space(3))) bf16x8*)(kp+2048); kf[3]=*(const __attribute__((address_space(3))) bf16x8*)(kp+2560);
  kf[4]=*(const __attribute__((address_space(3))) bf16x8*)(kp+4096); kf[5]=*(const __attribute__((address_space(3))) bf16x8*)(kp+4608);
  kf[6]=*(const __attribute__((address_space(3))) bf16x8*)(kp+6144); kf[7]=*(const __attribute__((address_space(3))) bf16x8*)(kp+6656);
}
__device__ __forceinline__ void kload2(bf16x8*kf,lds_cptr kp,int j){ kf[2*j]=*(const __attribute__((address_space(3))) bf16x8*)(kp+j*2048); kf[2*j+1]=*(const __attribute__((address_space(3))) bf16x8*)(kp+j*2048+512); }
__device__ __forceinline__ s16x4 vtr(lds_cptr p){ return __builtin_bit_cast(s16x4,__builtin_amdgcn_ds_read_tr16_b64_v4i16((__attribute__((address_space(3))) v4i16_t*)p)); }
__device__ __forceinline__ float rowmax(const f32x16&p0,const f32x16&p1){
  float a=max3f(p0[0],p0[1],p1[0]),b=max3f(p0[2],p0[3],p1[1]);a=max3f(a,p1[2],p1[3]);
  #pragma unroll
  for(int r=4;r<16;r+=4){a=max3f(a,p0[r],p0[r+1]);b=max3f(b,p0[r+2],p0[r+3]);a=max3f(a,p1[r],p1[r+1]);b=max3f(b,p1[r+2],p1[r+3]);}
  const float m=max2f(a,b);
  auto rr=__builtin_amdgcn_permlane32_swap(__float_as_uint(m),__float_as_uint(m),false,false);
  return max2f(__uint_as_float(rr[0]),__uint_as_float(rr[1]));
}
__device__ __forceinline__ void pv(f32x16*o,int vb,bf16x8 pa0,bf16x8 pa1,bf16x8 pa2,bf16x8 pa3){
  #pragma unroll
  for(int d0=0;d0<2;++d0){s16x4 lo[4],hi[4];
    #pragma unroll
    for(int ks=0;ks<4;++ks){
      asm volatile("ds_read_b64_tr_b16 %0,%1 offset:%c2":"=&v"(lo[ks]):"v"(vb),"i"(d0*4096+ks*1024):"memory");
      asm volatile("ds_read_b64_tr_b16 %0,%1 offset:%c2":"=&v"(hi[ks]):"v"(vb),"i"(d0*4096+ks*1024+512):"memory");}
    asm volatile("s_waitcnt lgkmcnt(0)":::"memory");SBAR();
    #define PK(k) (bf16x8){lo[k][0],lo[k][1],lo[k][2],lo[k][3],hi[k][0],hi[k][1],hi[k][2],hi[k][3]}
    o[d0]=__builtin_amdgcn_mfma_f32_32x32x16_bf16(pa0,PK(0),o[d0],0,0,0);
    o[d0]=__builtin_amdgcn_mfma_f32_32x32x16_bf16(pa1,PK(1),o[d0],0,0,0);
    o[d0]=__builtin_amdgcn_mfma_f32_32x32x16_bf16(pa2,PK(2),o[d0],0,0,0);
    o[d0]=__builtin_amdgcn_mfma_f32_32x32x16_bf16(pa3,PK(3),o[d0],0,0,0);
    #undef PK
  }
}
#define ATTN_STORE16(p,v) (*(u32x4*)(p)=(v))
template<int THRL> __device__ __forceinline__ void attn_unit(int combo,int q0,const bf16h*Q,const bf16h*__restrict__ K,const bf16h*__restrict__ V,bf16h*O,char*shm){
  int tid_=threadIdx.x; asm volatile("":"+v"(tid_));
  const int tid=tid_,lane=tid&63,r32=lane&31,hi=lane>>5; const int wid=__builtin_amdgcn_readfirstlane(tid>>6);
  const int vh_=combo&1,cp_=(combo>>1)&1,hh_=(combo>>2)&7; const long rowbase=(long)(combo>>5)*4096;
  const bf16h*Qw=Q+(rowbase+q0+wid*QBLK)*PITCH+(2*hh_+cp_)*D;
  const bf16h*Kh=K+rowbase*PITCH+(2*hh_+cp_)*D,*Vh=V+rowbase*PITCH+(2*hh_+vh_)*D;
  const unsigned lds0=(unsigned)(uintptr_t)shm;
  float*wsf=(float*)(shm+LDS_WS)+wid*64;
  const bf16h*ksrc=Kh+(long)lane*PITCH+wid*8;
  const bf16h*vsrc=Vh+(long)(16*(wid&3)+(lane>>2))*PITCH+(wid>>2)*32+(lane&3)*8;
  const unsigned kdst=lds0+LDS_K+wid*1024, vdst=lds0+LDS_V+wid*1024;
  #define DMA_K(t,slot) glds16(ksrc+(long)(t)*KVBLK*PITCH,(unsigned)__builtin_amdgcn_readfirstlane(kdst+(slot)))
  #define DMA_V(t,slot) glds16(vsrc+(long)(t)*KVBLK*PITCH,(unsigned)__builtin_amdgcn_readfirstlane(vdst+(slot)))
  const char*Kbase=shm+LDS_K; bf16x8 kf[8];
  const lds_cptr shm3=(lds_cptr)shm; const lds_cptr kp0=shm3+LDS_K+hi*1024+r32*16; const lds_cptr vp0=shm3+LDS_V+((lane>>4)&1)*32+(lane&3)*8+(4*hi+((lane&15)>>2))*64;
  const int NT=(q0+QB)/KVBLK;
  DMA_K(0,0);DMA_V(0,0);DMA_K(1,SLOTB);
  bf16x8 qr[4];
  #pragma unroll
  for(int d0=0;d0<4;++d0)qr[d0]=*reinterpret_cast<const bf16x8*>(&Qw[(long)r32*PITCH+d0*16+hi*8]);
  float mhat=0.f,l_reg=0.f;f32x16 o[2];o[0]=f32x16{};o[1]=f32x16{};
  const int qrel=wid*QBLK+r32;
  #define CMASK(P0,P1,t) do{int jb_=(t)-(NT-4); if(jb_>=0)cmask(P0,P1,jb_,qrel,hi);}while(0)
  bool resc=false;
  #define START(P0,P1) do{ const float rm=rowmax(P0,P1); resc=false; \
    { const float dl=rm; mhat=fadd_s(mhat,dl); \
      _Pragma("unroll") for(int r=0;r<16;++r){P0[r]=fsub_s(P0[r],dl);P1[r]=fsub_s(P1[r],dl);} \
      } \
    _Pragma("unroll") for(int r=0;r<16;++r)P0[r]=__builtin_amdgcn_exp2f(P0[r]); }while(0)
  #define RESC() do{ if(resc){ asm volatile("s_waitcnt lgkmcnt(0)":::"memory"); \
      _Pragma("unroll") for(int d_=0;d_<2;++d_) _Pragma("unroll") for(int r=0;r<16;++r)o[d_][r]*=wsf[crow(r,hi)]; } }while(0)
  f32x16 pA0,pA1,pB0,pB1;
  int sl_prev=0,sl_cur=0,sl_next=SLOTB;
  #define ROT() do{sl_prev=sl_cur;sl_cur=sl_next;sl_next=(sl_next==(NSLOT-1)*SLOTB)?0:sl_next+SLOTB;}while(0)
  DMA_K(2,2*SLOTB);
  WAIT_BAR(3);
  qkt(pA0,pA1,Kbase,qr,f32x16{},r32,hi);asm volatile("s_nop 15\n\ts_nop 7":"+v"(pA0),"+v"(pA1));CMASK(pA0,pA1,0);
  START(pA0,pA1);
  _Pragma("unroll") for(int r=0;r<16;++r)pA1[r]=__builtin_amdgcn_exp2f(pA1[r]);
  WAIT_BAR(0);
  DMA_K(3,0);DMA_V(1,SLOTB);
  ROT();
  kload8(kf,kp0+sl_cur);
  WAIT_BAR(2);
  s16x4 vlo[8],vhi[8]; u32x4 pw0,pw1,pw2,pw3;
  #define PKW(P,B) cvtpk_s(P[B],P[B+1])
  #define PAF(k) __builtin_bit_cast(bf16x8,pw##k)
  #define VFR(i) (bf16x8){vlo[i][0],vlo[i][1],vlo[i][2],vlo[i][3],vhi[i][0],vhi[i][1],vhi[i][2],vhi[i][3]}
  #define PIN(x) asm volatile("":"+v"(x))
  #define MX3(a,b,c) __builtin_fmaxf(__builtin_fmaxf((a),(b)),(c))
  #define GAPA(MF,A0,A1,A2,A3,W0,W1,PW) do{ MF; sacc+=A0; sacc+=A1; sacc+=A2; sacc+=A3; PIN(sacc); W0; W1; PIN(PW); SBAR(); }while(0)
  #define EX(v) __builtin_amdgcn_exp2f(v)
  #define GAPB(MF,X,B) do{ MF; X[B]=EX(X[B]); X[B+1]=EX(X[B+1]); X[B+2]=EX(X[B+2]); X[B+3]=EX(X[B+3]); PIN(X); SBAR(); }while(0)
  #define VRD(i) do{ vlo[i]=vtr(vp_+(((i)>>2)*4096+((i)&3)*1024)); vhi[i]=vtr(vp_+(((i)>>2)*4096+((i)&3)*1024+512)); }while(0)
  #define KRD(G,j) do{ if(G){ kload2(kf,kp0+sl_next,j); SBAR(); } }while(0)
  #define STEP(C0,C1,P0,P1,t,GK,GV,GL) do{ SBAR(); \
    const lds_cptr vp_=vp0+sl_prev; \
    VRD(0); SBAR(); float sacc=(P0[0]+P0[1]); \
    GAPA(C0=__builtin_amdgcn_mfma_f32_32x32x16_bf16(kf[0],qr[0],f32x16{},0,0,0), P0[2],P0[3],P0[4],P0[5],     pw0[0]=PKW(P0,0), pw0[1]=PKW(P0,2), pw0); \
    VRD(4); SBAR(); GAPA(C1=__builtin_amdgcn_mfma_f32_32x32x16_bf16(kf[1],qr[0],f32x16{},0,0,0), P0[6],P0[7],P0[8],P0[9],     pw0[2]=PKW(P0,4), pw0[3]=PKW(P0,6), pw0); \
    VRD(1); SBAR(); GAPA(C0=__builtin_amdgcn_mfma_f32_32x32x16_bf16(kf[2],qr[1],C0,0,0,0),   P0[10],P0[11],P0[12],P0[13], pw1[0]=PKW(P0,8), pw1[1]=PKW(P0,10), pw1); \
    VRD(5); SBAR(); GAPA(C1=__builtin_amdgcn_mfma_f32_32x32x16_bf16(kf[3],qr[1],C1,0,0,0),   P0[14],P0[15],P1[0],P1[1],   pw1[2]=PKW(P0,12),pw1[3]=PKW(P0,14), pw1); \
    VRD(2); SBAR(); GAPA(C0=__builtin_amdgcn_mfma_f32_32x32x16_bf16(kf[4],qr[2],C0,0,0,0),   P1[2],P1[3],P1[4],P1[5],     pw2[0]=PKW(P1,0), pw2[1]=PKW(P1,2), pw2); \
    VRD(6); SBAR(); GAPA(C1=__builtin_amdgcn_mfma_f32_32x32x16_bf16(kf[5],qr[2],C1,0,0,0),   P1[6],P1[7],P1[8],P1[9],     pw2[2]=PKW(P1,4), pw2[3]=PKW(P1,6), pw2); \
    VRD(3); SBAR(); GAPA(C0=__builtin_amdgcn_mfma_f32_32x32x16_bf16(kf[6],qr[3],C0,0,0,0),   P1[10],P1[11],P1[12],P1[13], pw3[0]=PKW(P1,8), pw3[1]=PKW(P1,10), pw3); \
    VRD(7); SBAR(); GAPA(C1=__builtin_amdgcn_mfma_f32_32x32x16_bf16(kf[7],qr[3],C1,0,0,0),   P1[14],P1[15],0.f,0.f,       pw3[2]=PKW(P1,12),pw3[3]=PKW(P1,14), pw3); \
    l_reg+=sacc; \
    if(GK){DMA_K((t)+3,sl_cur);} if(GV){DMA_V((t)+1,sl_next);} \
    _Pragma("unroll") for(int r=0;r<16;++r){C0[r]-=mhat;C1[r]-=mhat;} \
    CMASK(C0,C1,t); \
    { float a=MX3(C0[0],C0[1],C1[0]),b=MX3(C0[2],C0[3],C1[1]); a=MX3(a,C1[2],C1[3]); \
      _Pragma("unroll") for(int r=4;r<16;r+=4){a=MX3(a,C0[r],C0[r+1]);b=MX3(b,C0[r+2],C0[r+3]);a=MX3(a,C1[r],C1[r+1]);b=MX3(b,C1[r+2],C1[r+3]);} \
      float rm=__builtin_fmaxf(a,b); { auto rr=__builtin_amdgcn_permlane32_swap(__float_as_uint(rm),__float_as_uint(rm),false,false); rm=__builtin_fmaxf(__uint_as_float(rr[0]),__uint_as_float(rr[1])); } \
      resc=false; \
      if(__builtin_expect(__any(rm>(float)THRL),0)){ const float dl=__builtin_fmaxf(rm,0.f); mhat+=dl; \
        _Pragma("unroll") for(int r=0;r<16;++r){C0[r]-=dl;C1[r]-=dl;} \
        const float f=__builtin_amdgcn_exp2f(-dl); l_reg*=f; if(hi==0)wsf[r32]=f; resc=true; } } \
    SBAR(); \
    GAPB(o[0]=__builtin_amdgcn_mfma_f32_32x32x16_bf16(PAF(0),VFR(0),o[0],0,0,0), C0,0); \
    GAPB(o[1]=__builtin_amdgcn_mfma_f32_32x32x16_bf16(PAF(0),VFR(4),o[1],0,0,0), C0,4); \
    KRD(GL,0); GAPB(o[0]=__builtin_amdgcn_mfma_f32_32x32x16_bf16(PAF(1),VFR(1),o[0],0,0,0), C0,8); \
    KRD(GL,1); GAPB(o[1]=__builtin_amdgcn_mfma_f32_32x32x16_bf16(PAF(1),VFR(5),o[1],0,0,0), C0,12); \
    KRD(GL,2); GAPB(o[0]=__builtin_amdgcn_mfma_f32_32x32x16_bf16(PAF(2),VFR(2),o[0],0,0,0), C1,0); \
    KRD(GL,3); GAPB(o[1]=__builtin_amdgcn_mfma_f32_32x32x16_bf16(PAF(2),VFR(6),o[1],0,0,0), C1,4); \
    GAPB(o[0]=__builtin_amdgcn_mfma_f32_32x32x16_bf16(PAF(3),VFR(3),o[0],0,0,0), C1,8); \
    GAPB(o[1]=__builtin_amdgcn_mfma_f32_32x32x16_bf16(PAF(3),VFR(7),o[1],0,0,0), C1,12); \
    }while(0)
  int t=1;
  #undef CMASK
  #define CMASK(P0,P1,t) do{}while(0)
  for(;t+5<NT;t+=2){
    STEP(pB0,pB1,pA0,pA1,t,true,true,true);     WAIT_BAR(2); RESC(); ROT();
    STEP(pA0,pA1,pB0,pB1,t+1,true,true,true);   WAIT_BAR(2); RESC(); ROT();
  }
  #undef CMASK
  #define CMASK(P0,P1,t) do{int jb_=(t)-(NT-4); if(jb_>=0)cmask(P0,P1,jb_,qrel,hi);}while(0)
  #define ENDW(tt) do{ if((tt)+3<NT){WAIT_BAR(2);} else if((tt)+2<NT){WAIT_BAR(1);} else {WAIT_BAR(0);} }while(0)
  for(;t+1<NT;t+=2){
    STEP(pB0,pB1,pA0,pA1,t,(t+3<NT),(t+1<NT),(t+1<NT));       ENDW(t);   RESC(); ROT();
    STEP(pA0,pA1,pB0,pB1,t+1,(t+4<NT),(t+2<NT),(t+2<NT));     ENDW(t+1); RESC(); ROT();
  }
  STEP(pB0,pB1,pA0,pA1,NT-1,false,false,false); RESC();
  { float sacc=pB0[0]+pB0[1]; _Pragma("unroll") for(int r=2;r<16;++r)sacc+=pB0[r]; _Pragma("unroll") for(int r=0;r<16;++r)sacc+=pB1[r]; l_reg+=sacc;
    pw0=(u32x4){PKW(pB0,0),PKW(pB0,2),PKW(pB0,4),PKW(pB0,6)};pw1=(u32x4){PKW(pB0,8),PKW(pB0,10),PKW(pB0,12),PKW(pB0,14)};pw2=(u32x4){PKW(pB1,0),PKW(pB1,2),PKW(pB1,4),PKW(pB1,6)};pw3=(u32x4){PKW(pB1,8),PKW(pB1,10),PKW(pB1,12),PKW(pB1,14)};
    SBAR(); const int vb0=(int)(lds0+LDS_V)+((lane>>4)&1)*32+(lane&3)*8+(4*hi+((lane&15)>>2))*64; pv(o,vb0+sl_cur,PAF(0),PAF(1),PAF(2),PAF(3)); }
  #undef PKW
  #undef PAF
  #undef VFR
  #undef PIN
  #undef MX3
  #undef GAPA
  #undef GAPB
  #undef EX
  #undef VRD
  #undef KRD
  #undef STEP
  #undef ENDW
  {auto rr=__builtin_amdgcn_permlane32_swap(__float_as_uint(l_reg),__float_as_uint(l_reg),false,false);l_reg=__uint_as_float(rr[0])+__uint_as_float(rr[1]);}
  if(hi==0)wsf[32+r32]=l_reg;asm volatile("s_waitcnt lgkmcnt(0)":::"memory");
  float rli[16];
  #pragma unroll
  for(int r=0;r<16;++r)rli[r]=__builtin_amdgcn_rcpf(wsf[32+crow(r,hi)]);
  bf16h*Ow=O+((long)(combo>>5)*4096+q0+wid*QBLK)*OPITCH+((2*((combo>>2)&7)+((combo>>1)&1))*2+(combo&1))*D;
  { bf16h*stg=(bf16h*)(shm+LDS_OST)+wid*2048;
    #pragma unroll
    for(int r=0;r<16;++r){const int orow=crow(r,hi);
      #pragma unroll
      for(int d0=0;d0<2;++d0)stg[orow*64+d0*32+r32]=__float2bfloat16(o[d0][r]*rli[r]);}
    asm volatile("s_waitcnt lgkmcnt(0)":::"memory");
    #pragma unroll
    for(int i=0;i<4;++i){const int row=i*8+(lane>>3),ch=lane&7; const u32x4 v=*(const u32x4*)(stg+row*64+ch*8); ATTN_STORE16(Ow+(long)row*OPITCH+ch*8,v);} }
  asm volatile("s_waitcnt lgkmcnt(0)\n\ts_barrier":::"memory");
  #undef DMA_K
  #undef DMA_V
  #undef CMASK
  #undef START
  #undef RESC
  #undef ROT
}
constexpr int ATTN_LDS_BYTES=LDS_BYTES;
#undef SBAR
#undef WAIT_BAR
}


namespace dattn {
using bf16h = __hip_bfloat16;
using bf16x8 = __attribute__((ext_vector_type(8))) short;
using s16x4 = __attribute__((ext_vector_type(4))) short;
using f32x16 = __attribute__((ext_vector_type(16))) float;
using u32x4 = __attribute__((ext_vector_type(4))) unsigned;
using f32x4v = __attribute__((ext_vector_type(4))) float;
constexpr int PITCH = 1024, KSLOT = 16384, VSLOT = 16384, LDS_K = 0, LDS_V = 3 * KSLOT, LDS_WS = LDS_V + 3 * VSLOT, LDS_END = LDS_WS + 8 * 256;
constexpr int LDS_X = 0, LDS_OST = 65536;
static_assert(LDS_END <= 131072 && LDS_OST + 4 * 8192 <= LDS_WS, "dattn LDS map");
typedef __attribute__((address_space(3))) const char* lds_cptr;
typedef short v4i16_t __attribute__((ext_vector_type(4)));
__device__ __forceinline__ int crow(int r, int hi) { return (r & 3) + 8 * (r >> 2) + 4 * hi; }
__device__ __forceinline__ void glds16(const void* gsrc, unsigned lds_dst) { unsigned keep;
    asm volatile("s_mov_b32 %0, m0\n\ts_mov_b32 m0, %2\n\ts_nop 0\n\tglobal_load_lds_dwordx4 %1, off\n\ts_mov_b32 m0, %0" : "=&s"(keep) : "v"(gsrc), "s"(lds_dst) : "memory"); }
__device__ __forceinline__ void glds16s(const void* sbase, unsigned voff, unsigned lds_dst) { unsigned keep;
    asm volatile("s_mov_b32 %0, m0\n\ts_mov_b32 m0, %3\n\ts_nop 0\n\tglobal_load_lds_dwordx4 %1, %2\n\ts_mov_b32 m0, %0" : "=&s"(keep) : "v"(voff), "s"(sbase), "s"(lds_dst) : "memory"); }
__device__ __forceinline__ s16x4 vtr(lds_cptr p) { return __builtin_bit_cast(s16x4, __builtin_amdgcn_ds_read_tr16_b64_v4i16((__attribute__((address_space(3))) v4i16_t*)p)); }
__device__ __forceinline__ unsigned cvtpk(float lo, float hi) { return cvt_pk_bf16(lo, hi); }
__device__ __forceinline__ float xhalf_max(float m) { auto rr = __builtin_amdgcn_permlane32_swap(__float_as_uint(m), __float_as_uint(m), false, false); return fmaxf(__uint_as_float(rr[0]), __uint_as_float(rr[1])); }
__device__ __forceinline__ float xhalf_sum(float m) { auto rr = __builtin_amdgcn_permlane32_swap(__float_as_uint(m), __float_as_uint(m), false, false); return __uint_as_float(rr[0]) + __uint_as_float(rr[1]); }
#define DA_WAIT_BAR(N) asm volatile("s_waitcnt vmcnt(" #N ") lgkmcnt(0)\n\ts_barrier" ::: "memory")

template <int THRL>
__device__ __forceinline__ void unit(int bh, int qb, const bf16h* Q, const bf16h* __restrict__ K, const bf16h* __restrict__ V, bf16h* O, float lam, const f32x4v gA, const f32x4v gB, char* shm) {
    int tid_ = threadIdx.x; asm volatile("" : "+v"(tid_));
    const int tid = tid_, lane = tid & 63, r32 = lane & 31, hi = lane >> 5; const int wid = __builtin_amdgcn_readfirstlane(tid >> 6);
    const int comp = wid >> 2, wq = wid & 3, h = bh & 7; const long rowbase = (long)(bh >> 3) * 4096; const int q0 = qb * 128;
    const bf16h* Qw = Q + (rowbase + q0 + wq * 32) * PITCH + (2 * h + comp) * 64;
    const unsigned lds0 = (unsigned)(uintptr_t)shm;
    const lds_cptr shm3 = (lds_cptr)shm;
    __attribute__((address_space(3))) float* wsf = (__attribute__((address_space(3))) float*)(shm3 + LDS_WS) + wid * 64;
    const bf16h* ksrc = K + rowbase * PITCH + (2 * h) * 64 + wid * 8;
    const bf16h* vsrc = V + rowbase * PITCH + h * 128 + (long)(16 * (wid & 3)) * PITCH + (wid >> 2) * 32;
    const unsigned kvoff = (unsigned)lane * PITCH * 2u, vvoff = ((unsigned)(lane >> 2) * PITCH + (unsigned)(lane & 3) * 8u) * 2u;
    const unsigned kdst = lds0 + LDS_K + wid * 1024, vdst = lds0 + LDS_V + wid * 1024;
#define DA_DMA_K(t, slot) do { glds16s(ksrc + (long)(t) * 64 * PITCH, kvoff, (unsigned)__builtin_amdgcn_readfirstlane(kdst + (slot))); glds16s(ksrc + (long)(t) * 64 * PITCH + 64, kvoff, (unsigned)__builtin_amdgcn_readfirstlane(kdst + (slot) + 8192)); } while (0)
#define DA_DMA_V(t, slot) do { glds16s(vsrc + (long)(t) * 64 * PITCH, vvoff, (unsigned)__builtin_amdgcn_readfirstlane(vdst + (slot))); glds16s(vsrc + (long)(t) * 64 * PITCH + 64, vvoff, (unsigned)__builtin_amdgcn_readfirstlane(vdst + (slot) + 8192)); } while (0)
    const lds_cptr kp0 = shm3 + LDS_K + comp * 8192 + hi * 1024 + r32 * 16;
    const lds_cptr vp0 = shm3 + LDS_V + ((lane >> 4) & 1) * 32 + (lane & 3) * 8 + (4 * hi + ((lane & 15) >> 2)) * 64;
    const int NT = (q0 + 128) / 64;
    bf16x8 qr[4];
#pragma unroll
    for (int d0 = 0; d0 < 4; ++d0) qr[d0] = *reinterpret_cast<const bf16x8*>(&Qw[(long)r32 * PITCH + d0 * 16 + hi * 8]);
    DA_DMA_K(0, 0); DA_DMA_V(0, 0); DA_DMA_K(1, KSLOT);
    float l_reg = 0.f; f32x16 o[4];
#pragma unroll
    for (int d = 0; d < 4; ++d)
#pragma unroll
        for (int r = 0; r < 16; ++r) o[d][r] = 0.f;
    u32x4 pw0 = {0u, 0u, 0u, 0u}, pw1 = pw0, pw2 = pw0, pw3 = pw0;
    const int qrel = wq * 32 + r32;
    int ks_cur = 0, ks_n2 = 2 * KSLOT;
    int vs_cur = 0, vs_n1 = VSLOT, vs_prev = 2 * VSLOT;
#define DA_SB() __builtin_amdgcn_sched_barrier(0)
#define DA_KRD() do { const lds_cptr kp = kp0 + ks_cur; \
        _Pragma("unroll") for (int d0 = 0; d0 < 4; ++d0) { kf[2 * d0] = *(const __attribute__((address_space(3))) bf16x8*)(kp + d0 * 2048); kf[2 * d0 + 1] = *(const __attribute__((address_space(3))) bf16x8*)(kp + d0 * 2048 + 512); } DA_SB(); } while (0)
#define DA_QK(t) do { \
        p0 = __builtin_amdgcn_mfma_f32_32x32x16_bf16(kf[0], qr[0], f32x16{}, 0, 0, 0); p1 = __builtin_amdgcn_mfma_f32_32x32x16_bf16(kf[1], qr[0], f32x16{}, 0, 0, 0); \
        _Pragma("unroll") for (int d0 = 1; d0 < 4; ++d0) { p0 = __builtin_amdgcn_mfma_f32_32x32x16_bf16(kf[2 * d0], qr[d0], p0, 0, 0, 0); p1 = __builtin_amdgcn_mfma_f32_32x32x16_bf16(kf[2 * d0 + 1], qr[d0], p1, 0, 0, 0); } \
        DA_SB(); \
        const int jb = (t) - (NT - 2); \
        if (jb >= 0) { const int kb = 64 * jb + 4 * hi; \
            _Pragma("unroll") for (int r = 0; r < 16; ++r) { const int kv = kb + (r & 3) + 8 * (r >> 2); if (kv > qrel) p0[r] = -INFINITY; if (kv + 32 > qrel) p1[r] = -INFINITY; } } } while (0)
#define DA_SOFTMAX(t) do { \
        float rm = fmaxf(p0[0], p1[0]); \
        _Pragma("unroll") for (int r = 1; r < 16; ++r) rm = fmaxf(rm, fmaxf(p0[r], p1[r])); \
        rm = xhalf_max(rm); \
        if ((t) == 0) { mhat = rm; } \
        else if (__any(rm > mhat + (float)THRL)) { const float dl = fmaxf(rm - mhat, 0.f); mhat += dl; const float f = __builtin_amdgcn_exp2f(-dl); l_reg *= f; \
            if (hi == 0) wsf[r32] = f; asm volatile("s_waitcnt lgkmcnt(0)" ::: "memory"); \
            _Pragma("unroll") for (int g4 = 0; g4 < 4; ++g4) { const f32x4v fv = *(const __attribute__((address_space(3))) f32x4v*)(wsf + 8 * g4 + 4 * hi); \
                _Pragma("unroll") for (int d = 0; d < 4; ++d) { o[d][4 * g4] *= fv[0]; o[d][4 * g4 + 1] *= fv[1]; o[d][4 * g4 + 2] *= fv[2]; o[d][4 * g4 + 3] *= fv[3]; } } } \
        float sacc = 0.f; \
        _Pragma("unroll") for (int r = 0; r < 16; ++r) { p0[r] = __builtin_amdgcn_exp2f(p0[r] - mhat); p1[r] = __builtin_amdgcn_exp2f(p1[r] - mhat); sacc += p0[r] + p1[r]; } \
        l_reg += sacc; \
        pw0 = (u32x4){cvtpk(p0[0], p0[1]), cvtpk(p0[2], p0[3]), cvtpk(p0[4], p0[5]), cvtpk(p0[6], p0[7])}; pw1 = (u32x4){cvtpk(p0[8], p0[9]), cvtpk(p0[10], p0[11]), cvtpk(p0[12], p0[13]), cvtpk(p0[14], p0[15])}; \
        pw2 = (u32x4){cvtpk(p1[0], p1[1]), cvtpk(p1[2], p1[3]), cvtpk(p1[4], p1[5]), cvtpk(p1[6], p1[7])}; pw3 = (u32x4){cvtpk(p1[8], p1[9]), cvtpk(p1[10], p1[11]), cvtpk(p1[12], p1[13]), cvtpk(p1[14], p1[15])}; DA_SB(); } while (0)
#define DA_VRD(VF, vslot, g) do { const lds_cptr vp = vp0 + (vslot) + (g) * 8192; \
        _Pragma("unroll") for (int i = 0; i < 8; ++i) { VF[2 * i] = vtr(vp + (i >> 2) * 4096 + (i & 3) * 1024); VF[2 * i + 1] = vtr(vp + (i >> 2) * 4096 + (i & 3) * 1024 + 512); } DA_SB(); } while (0)
#define DA_PVM(VF, g) do { \
        _Pragma("unroll") for (int i = 0; i < 8; ++i) { const s16x4 lo = VF[2 * i], hi4 = VF[2 * i + 1]; \
            const bf16x8 vf = (bf16x8){lo[0], lo[1], lo[2], lo[3], hi4[0], hi4[1], hi4[2], hi4[3]}; \
            const bf16x8 pa = __builtin_bit_cast(bf16x8, (i & 3) == 0 ? pw0 : (i & 3) == 1 ? pw1 : (i & 3) == 2 ? pw2 : pw3); \
            o[2 * (g) + (i >> 2)] = __builtin_amdgcn_mfma_f32_32x32x16_bf16(pa, vf, o[2 * (g) + (i >> 2)], 0, 0, 0); } DA_SB(); } while (0)
    bf16x8 kf[8]; s16x4 vfa[16], vfb[16];
    f32x16 p0, p1;
#define DA_STEP(t, HASPV) do { \
        if ((t) + 1 < NT) { DA_WAIT_BAR(2); } else { DA_WAIT_BAR(0); }            \
        const bool gv = (t) + 1 < NT, gk = (t) + 2 < NT; \
        DA_KRD(); \
        if (HASPV) DA_VRD(vfa, vs_prev, 0); \
        if (gv) glds16s(vsrc + (long)((t) + 1) * 64 * PITCH, vvoff, (unsigned)__builtin_amdgcn_readfirstlane(vdst + vs_n1)); \
        DA_QK(t); \
        if (HASPV) DA_VRD(vfb, vs_prev, 1); \
        if (gv) glds16s(vsrc + (long)((t) + 1) * 64 * PITCH + 64, vvoff, (unsigned)__builtin_amdgcn_readfirstlane(vdst + vs_n1 + 8192)); \
          \
        if (gk) glds16s(ksrc + (long)((t) + 2) * 64 * PITCH, kvoff, (unsigned)__builtin_amdgcn_readfirstlane(kdst + ks_n2)); \
        DA_SB(); \
          \
        if (HASPV) { \
            _Pragma("unroll") for (int i = 0; i < 8; ++i) { const s16x4 lo = vfa[2 * i], hi4 = vfa[2 * i + 1]; const bf16x8 vf = (bf16x8){lo[0], lo[1], lo[2], lo[3], hi4[0], hi4[1], hi4[2], hi4[3]}; \
                const bf16x8 pa = __builtin_bit_cast(bf16x8, (i & 3) == 0 ? pw0 : (i & 3) == 1 ? pw1 : (i & 3) == 2 ? pw2 : pw3); o[i >> 2] = __builtin_amdgcn_mfma_f32_32x32x16_bf16(pa, vf, o[i >> 2], 0, 0, 0); } \
            _Pragma("unroll") for (int i = 0; i < 8; ++i) { const s16x4 lo = vfb[2 * i], hi4 = vfb[2 * i + 1]; const bf16x8 vf = (bf16x8){lo[0], lo[1], lo[2], lo[3], hi4[0], hi4[1], hi4[2], hi4[3]}; \
                const bf16x8 pa = __builtin_bit_cast(bf16x8, (i & 3) == 0 ? pw0 : (i & 3) == 1 ? pw1 : (i & 3) == 2 ? pw2 : pw3); o[2 + (i >> 2)] = __builtin_amdgcn_mfma_f32_32x32x16_bf16(pa, vf, o[2 + (i >> 2)], 0, 0, 0); } } \
        float sacc = 0.f; \
        _Pragma("unroll") for (int r = 0; r < 16; ++r) { p0[r] = __builtin_amdgcn_exp2f(p0[r]); p1[r] = __builtin_amdgcn_exp2f(p1[r]); sacc += p0[r] + p1[r]; } \
        if (HASPV) { _Pragma("unroll") for (int i = 0; i < 16; ++i) { __builtin_amdgcn_sched_group_barrier(0x008, 1, 0); __builtin_amdgcn_sched_group_barrier(0x002, 6, 0); } } \
        DA_SB(); \
        if (gk) glds16s(ksrc + (long)((t) + 2) * 64 * PITCH + 64, kvoff, (unsigned)__builtin_amdgcn_readfirstlane(kdst + ks_n2 + 8192)); \
        l_reg += sacc; \
        pw0 = (u32x4){cvtpk(p0[0], p0[1]), cvtpk(p0[2], p0[3]), cvtpk(p0[4], p0[5]), cvtpk(p0[6], p0[7])}; pw1 = (u32x4){cvtpk(p0[8], p0[9]), cvtpk(p0[10], p0[11]), cvtpk(p0[12], p0[13]), cvtpk(p0[14], p0[15])}; \
        pw2 = (u32x4){cvtpk(p1[0], p1[1]), cvtpk(p1[2], p1[3]), cvtpk(p1[4], p1[5]), cvtpk(p1[6], p1[7])}; pw3 = (u32x4){cvtpk(p1[8], p1[9]), cvtpk(p1[10], p1[11]), cvtpk(p1[12], p1[13]), cvtpk(p1[14], p1[15])}; \
        DA_SB(); \
        { const int k_ = ks_cur; ks_cur = (ks_cur == 2 * KSLOT) ? 0 : ks_cur + KSLOT; ks_n2 = k_; }     \
        { vs_prev = vs_cur; vs_cur = vs_n1; vs_n1 = (vs_n1 == 2 * VSLOT) ? 0 : vs_n1 + VSLOT; } } while (0)
    DA_STEP(0, false);
    for (int t = 1; t < NT; ++t) DA_STEP(t, true);
#undef DA_STEP
    { DA_VRD(vfa, vs_prev, 0); DA_VRD(vfb, vs_prev, 1); DA_PVM(vfa, 0); DA_PVM(vfb, 1); }
    { const float lt = xhalf_sum(l_reg); if (hi == 0) wsf[r32] = 1.0f / lt; asm volatile("s_waitcnt lgkmcnt(0)" ::: "memory");
#pragma unroll
      for (int g4 = 0; g4 < 4; ++g4) { const f32x4v fv = *(const __attribute__((address_space(3))) f32x4v*)(wsf + 8 * g4 + 4 * hi);
#pragma unroll
          for (int d = 0; d < 4; ++d) { o[d][4 * g4] *= fv[0]; o[d][4 * g4 + 1] *= fv[1]; o[d][4 * g4 + 2] *= fv[2]; o[d][4 * g4 + 3] *= fv[3]; } } }
    DA_WAIT_BAR(0);
    __attribute__((address_space(3))) float* X = (__attribute__((address_space(3))) float*)(shm3 + LDS_X) + wq * 4096 + lane;
    if (comp == 1) {
#pragma unroll
        for (int r = 0; r < 16; ++r)
#pragma unroll
            for (int d = 0; d < 4; ++d) X[(r * 4 + d) * 64] = o[d][r];
    }
    DA_WAIT_BAR(0);
    if (comp == 0) {
        __attribute__((address_space(3))) unsigned short* stg = (__attribute__((address_space(3))) unsigned short*)(shm3 + LDS_OST) + wq * 4096;
#pragma unroll
        for (int r = 0; r < 16; ++r) { const int orow = crow(r, hi);
#pragma unroll
            for (int d = 0; d < 4; ++d) { const float a = o[d][r] - lam * X[(r * 4 + d) * 64]; stg[orow * 128 + d * 32 + r32] = (unsigned short)(cvtpk(a, 0.f) & 0xffffu); } }
        asm volatile("s_waitcnt lgkmcnt(0)" ::: "memory");
        bf16h* Ow = O + (rowbase + q0 + wq * 32) * PITCH + h * 128;
        const int ch = lane & 15;
#pragma unroll
        for (int i = 0; i < 8; ++i) { const int row = i * 4 + (lane >> 4);
            const u32x4 v = *(const __attribute__((address_space(3))) u32x4*)(stg + row * 128 + ch * 8);
            float a[8];
#pragma unroll
            for (int j = 0; j < 4; ++j) { a[2 * j] = __uint_as_float(v[j] << 16); a[2 * j + 1] = __uint_as_float(v[j] & 0xffff0000u); }
            float ss = 0.f;
#pragma unroll
            for (int j = 0; j < 8; ++j) ss += a[j] * a[j];
            ss = sum_lanes16(ss);
            const float rs = rsqrtf(ss * (1.0f / 128.0f) + 1e-6f);
            u32x4 w; w[0] = cvtpk(a[0] * rs * gA[0], a[1] * rs * gA[1]); w[1] = cvtpk(a[2] * rs * gA[2], a[3] * rs * gA[3]); w[2] = cvtpk(a[4] * rs * gB[0], a[5] * rs * gB[1]); w[3] = cvtpk(a[6] * rs * gB[2], a[7] * rs * gB[3]);
            *(u32x4*)(Ow + (long)row * PITCH + ch * 8) = w; }
    }
    DA_WAIT_BAR(0);
#undef DA_DMA_K
#undef DA_DMA_V
#undef DA_QK
#undef DA_SOFTMAX
#undef DA_PVM
#undef DA_VRD
#undef DA_KRD
#undef DA_SB
}
#undef DA_WAIT_BAR
}

constexpr size_t MiB = 1u << 20;
constexpr size_t WS_CTL = 0, CTL_ZERO_BYTES = 1 * MiB;
constexpr size_t WS_MODF = 1 * MiB;
constexpr size_t WS_LAM = 1 * MiB + 512 * 1024;
constexpr size_t WS_BGUP = 2 * MiB;
constexpr size_t WS_RWT = 3 * MiB;
constexpr size_t WS_ROPE = 4 * MiB;
constexpr size_t WS_WQKV = 12 * MiB, WS_WO = 18 * MiB, WS_WML = 20 * MiB, WS_WMLO = 27 * MiB;
constexpr size_t WS_TOKE = 29 * MiB, WS_GATE = 30 * MiB, WS_LIST = 31 * MiB, WS_IG = 35 * MiB, WS_LF = 36 * MiB;
constexpr size_t WS_SSQ = 37 * MiB;
constexpr size_t WS_WGU = 64 * MiB, WS_WDN = 320 * MiB;
constexpr size_t WS_H = 448 * MiB, WS_Q = 512 * MiB, WS_K = 576 * MiB, WS_V = 640 * MiB;
constexpr size_t WS_MQ = 512 * MiB, WS_MK = 544 * MiB, WS_MV = 576 * MiB, WS_MO = 640 * MiB;
constexpr size_t WS_OB = 704 * MiB, WS_ATTC = 832 * MiB, WS_X1 = 896 * MiB, WS_X2 = 1024 * MiB;
constexpr size_t WS_ACT = 1152 * MiB, WS_Y = 1424 * MiB, WS_END = 1696 * MiB;
static_assert(WS_ACT + (size_t)MAXMT * 256 * 1024 * 2 <= WS_Y && WS_Y + (size_t)MAXMT * 256 * 1024 * 2 <= WS_END, "ws map");
constexpr size_t WS_CTS = WS_OB, WS_NS = WS_OB + 8 * MiB, WS_GS = WS_OB + 9 * MiB;
constexpr int CW_TMO = 0, CW_BAR = 4096, CW_CNT = 8192;

constexpr int RING_BYTES = 131072;
constexpr int LDSCTL_OFF = RING_BYTES;
constexpr int LT_MISC = 0;
constexpr int LT_CNT = 64, LT_TSTART = 64 + 32 * 4, LT_TILEE = 64 + 32 * 4 + 36 * 4;
constexpr int LDS_BYTES = 163840;
static_assert(LT_TILEE + MAXMT * 4 <= LDS_BYTES - LDSCTL_OFF, "LDS tables");

#define XB_TMO      128
#define XB_XCNT(j)  (256  + 64 * (j))
#define XB_XSUB(j)  (1280 + 64 * (j))
#define XB_XGEN(j)  (2304 + 64 * (j))
#define XB_TOP      3328
#define XB_TOPGEN   3392
#define XCD_BAR_WORDS 3456
#define XB_SPIN_CAP (1u << 18)
__device__ __forceinline__ unsigned xb_ld(unsigned* p)              { return __hip_atomic_load(p, __ATOMIC_RELAXED, __HIP_MEMORY_SCOPE_AGENT); }
__device__ __forceinline__ unsigned xb_add(unsigned* p, unsigned v) { return __hip_atomic_fetch_add(p, v, __ATOMIC_RELAXED, __HIP_MEMORY_SCOPE_AGENT); }
__device__ __forceinline__ unsigned xb_xcc_id() { return (unsigned)__builtin_amdgcn_s_getreg((3 << 11) | 20) & 0xFu; }
#define XB_SPIN(cond, bar) do { unsigned _sp = 0; while (cond) { __builtin_amdgcn_s_sleep(1); \
    if ((++_sp & 255u) == 0u) { if (xb_ld(&(bar)[XB_TMO])) break; if (_sp > XB_SPIN_CAP) { atomicAdd(&(bar)[XB_TMO], 1u); break; } } } } while (0)
struct XcdBarrier { unsigned* bar; unsigned x; volatile LAS unsigned* st; };
__device__ __forceinline__ XcdBarrier xcd_barrier_post(unsigned* bar, volatile LAS unsigned* st) {
    XcdBarrier b; b.bar = bar; b.x = xb_xcc_id(); b.st = st;
    if (threadIdx.x == 0) (void)xb_add(&bar[XB_XCNT(b.x)], 1u);
    return b;
}
__device__ __forceinline__ void xcd_barrier_complete(unsigned* bar, unsigned x, unsigned& nloc, unsigned& nx) {
    const unsigned G = gridDim.x * gridDim.y * gridDim.z;
    unsigned sum, cnt, mine, sp = 0u;
    for (;;) {
        sum = 0u; cnt = 0u; mine = 0u;
#pragma unroll
        for (unsigned j = 0; j < 16; ++j) { const unsigned c = xb_ld(&bar[XB_XCNT(j)]); sum += c; cnt += (c > 0u) ? 1u : 0u; mine = (j == x) ? c : mine; }
        if (sum == G) break;
        __builtin_amdgcn_s_sleep(1);
        if ((++sp & 255u) == 0u) { if (xb_ld(&bar[XB_TMO])) break; if (sp > XB_SPIN_CAP) { atomicAdd(&bar[XB_TMO], 1u); break; } }
    }
    nloc = mine > 0u ? mine : 1u; nx = cnt > 0u ? cnt : 1u;
}
__device__ __forceinline__ void xcd_barrier(const XcdBarrier& b) {
    asm volatile("s_waitcnt vmcnt(0)" ::: "memory");
    __syncthreads();
    if (threadIdx.x == 0) {
        unsigned* bar = b.bar;
        __builtin_amdgcn_s_waitcnt(0);
        unsigned nloc = b.st[0], nx = b.st[1];
        if (nloc == 0u) { xcd_barrier_complete(bar, b.x, nloc, nx); b.st[0] = nloc; b.st[1] = nx; }
        const unsigned old = xb_add(&bar[XB_XSUB(b.x)], 1u);
        const unsigned gen = old / nloc;
        if (old + 1u == (gen + 1u) * nloc) {
            __builtin_amdgcn_fence(__ATOMIC_RELEASE, "agent");
            asm volatile("s_waitcnt vmcnt(0)" ::: "memory");
            const unsigned og = xb_add(&bar[XB_TOP], 1u);
            const unsigned tg = og / nx;
            if (og + 1u == (tg + 1u) * nx) xb_add(&bar[XB_TOPGEN], 1u);
            else XB_SPIN(xb_ld(&bar[XB_TOPGEN]) == tg, bar);
            __builtin_amdgcn_fence(__ATOMIC_ACQUIRE, "agent");
            xb_add(&bar[XB_XGEN(b.x)], 1u);
            asm volatile("s_waitcnt vmcnt(0)" ::: "memory");
        } else {
            XB_SPIN(xb_ld(&bar[XB_XGEN(b.x)]) == gen, bar);
            __builtin_amdgcn_fence(__ATOMIC_ACQUIRE, "agent");
            asm volatile("s_waitcnt vmcnt(0)" ::: "memory");
        }
    }
    __syncthreads();
}

struct Params {
    const float* in[27];
    float* out;
    unsigned char* ws;
    float invf[32];
};
enum { I_X = 0, I_C, I_POS, I_ADAW, I_ADAB, I_MIXN, I_FFNN, I_AWIN, I_AWOUT, I_AQN, I_AKN, I_LQ1, I_LK1, I_LQ2, I_LK2, I_ASUB,
       I_MWIN, I_MBI, I_MBF, I_MON, I_MWOUT, I_RW, I_RB, I_WGU, I_BGU, I_WDN, I_BDN };

template <bool F8Q> struct EpiQKV {
    static constexpr float SC = F8Q ? WSCALE_INV : 1.0f;
    bf16 *Q, *K, *V; const float* rope; const float *qg, *kg;
    __device__ __forceinline__ void prefetch(pg8::EpiPre& p, const pg8::Unit& u, int wr, int wc, int fr, int fq) const {
        const float* gn = u.pn < 4 ? qg : kg;
#pragma unroll
        for (int bj = 0; bj < 2; ++bj)
#pragma unroll
            for (int n = 0; n < 2; ++n) p.v[2 * bj + n] = *(const f32x4*)(gn + 32 * bj + 8 * fq + 4 * n);
    }
    __device__ __forceinline__ void operator()(const f32x4 (&acc)[2][2][4][2], const pg8::Unit& u, int wr, int wc, int fr, int fq, const pg8::EpiPre& pre) const {
        const int row0 = u.pm * 256 + wr * 64 + fr;
        if (u.pn < 8) {
            const bool isq = u.pn < 4; bf16* base = isq ? Q : K; const float osc = isq ? C2Q : 1.0f;
            const int vec = (u.pn & 3) * 4 + wc;
            f32x4 g[2][2];
#pragma unroll
            for (int bj = 0; bj < 2; ++bj)
#pragma unroll
                for (int n = 0; n < 2; ++n) g[bj][n] = pre.v[2 * bj + n];
#pragma unroll
            for (int ai = 0; ai < 2; ++ai)
#pragma unroll
                for (int m = 0; m < 4; ++m) {
                    const int row = row0 + ai * 128 + m * 16;
                    float ss = 0.f;
#pragma unroll
                    for (int bj = 0; bj < 2; ++bj)
#pragma unroll
                        for (int n = 0; n < 2; ++n) { const f32x4 x = acc[ai][bj][m][n]; ss += (x[0] * x[0] + x[1] * x[1]) + (x[2] * x[2] + x[3] * x[3]); }
                    ss = sum_fq4(ss);
                    const float rs = rsqrtf(ss * (SC * SC / 64.0f) + RMS_EPS) * SC;
                    const float* rp = rope + (size_t)row * 64 + 8 * fq;
                    v4u w1, w2;
#pragma unroll
                    for (int n = 0; n < 2; ++n) {
                        const f32x4 cs = *(const f32x4*)(rp + 4 * n), sn = *(const f32x4*)(rp + 32 + 4 * n);
                        const f32x4 y1 = acc[ai][0][m][n] * rs * g[0][n], y2 = acc[ai][1][m][n] * rs * g[1][n];
                        const f32x4 o1 = (y1 * cs - y2 * sn) * osc, o2 = (y2 * cs + y1 * sn) * osc;
                        w1[2 * n] = cvt_pk_bf16(o1[0], o1[1]); w1[2 * n + 1] = cvt_pk_bf16(o1[2], o1[3]);
                        w2[2 * n] = cvt_pk_bf16(o2[0], o2[1]); w2[2 * n + 1] = cvt_pk_bf16(o2[2], o2[3]);
                    }
                    bf16* p = base + (size_t)row * 1024 + vec * 64 + 8 * fq;
                    *(v4u*)p = w1; *(v4u*)(p + 32) = w2;
                }
        } else {
            const int col0 = (u.pn - 8) * 256 + wc * 32 + 8 * fq;
#pragma unroll
            for (int ai = 0; ai < 2; ++ai)
#pragma unroll
                for (int m = 0; m < 4; ++m) { bf16* rowp = V + (size_t)(row0 + ai * 128 + m * 16) * 1024 + col0;
#pragma unroll
                    for (int bj = 0; bj < 2; ++bj) { const f32x4 v0 = acc[ai][bj][m][0] * SC, v1 = acc[ai][bj][m][1] * SC; v4u w;
                        w.x = cvt_pk_bf16(v0[0], v0[1]); w.y = cvt_pk_bf16(v0[2], v0[3]); w.z = cvt_pk_bf16(v1[0], v1[1]); w.w = cvt_pk_bf16(v1[2], v1[3]);
                        *(v4u*)(rowp + bj * 128) = w; } }
        }
    }
};
struct EpiResid {
    const float* xin; const bf16* xinb; bf16* xout; const float* gvec; float* ssq;
    __device__ __forceinline__ void prefetch(pg8::EpiPre& p, const pg8::Unit& u, int wr, int wc, int fr, int fq) const {
        const int b = u.pm >> 4, col0 = u.pn * 256 + wc * 32 + 8 * fq;
#pragma unroll
        for (int bj = 0; bj < 2; ++bj)
#pragma unroll
            for (int n = 0; n < 2; ++n) p.v[2 * bj + n] = *(const f32x4*)(gvec + (size_t)b * 6144 + col0 + bj * 128 + 4 * n);
    }
    __device__ __forceinline__ void operator()(const f32x4 (&acc)[2][2][4][2], const pg8::Unit& u, int wr, int wc, int fr, int fq, const pg8::EpiPre& pre) const {
        const int row0 = u.pm * 256 + wr * 64 + fr, col0 = u.pn * 256 + wc * 32 + 8 * fq;
        f32x4 g[2][2];
#pragma unroll
        for (int bj = 0; bj < 2; ++bj)
#pragma unroll
            for (int n = 0; n < 2; ++n) g[bj][n] = pre.v[2 * bj + n];
#pragma unroll
        for (int ai = 0; ai < 2; ++ai)
#pragma unroll
            for (int m = 0; m < 4; ++m) { const size_t off = (size_t)(row0 + ai * 128 + m * 16) * 1024 + col0; float ss = 0.f;
#pragma unroll
                for (int bj = 0; bj < 2; ++bj) { v4u w;
#pragma unroll
                    for (int n = 0; n < 2; ++n) { f32x4 xi; if (xinb) { const v2u xw = *(const v2u*)(xinb + off + bj * 128 + 4 * n); xi = (f32x4){bf_lo(xw.x), bf_hi(xw.x), bf_lo(xw.y), bf_hi(xw.y)}; } else xi = __builtin_nontemporal_load((const f32x4*)(xin + off + bj * 128 + 4 * n));
                        const f32x4 xo = xi + g[bj][n] * acc[ai][bj][m][n];
                        w[2 * n] = cvt_pk_bf16(xo[0], xo[1]); w[2 * n + 1] = cvt_pk_bf16(xo[2], xo[3]);
                        const float r0 = bf_lo(w[2 * n]), r1 = bf_hi(w[2 * n]), r2 = bf_lo(w[2 * n + 1]), r3 = bf_hi(w[2 * n + 1]);
                        ss += (r0 * r0 + r1 * r1) + (r2 * r2 + r3 * r3); }
                    *(v4u*)(xout + off + bj * 128) = w; }
                ss = sum_fq4(ss);
                if (fq == 0) ssq[(size_t)(row0 + ai * 128 + m * 16) * 16 + u.pn * 4 + wc] = ss; }
    }
};
__device__ __forceinline__ float softcap15(float z) { const float x = z * (1.0f / 15.0f); const float e = __expf(2.0f * x); return 15.0f * (1.0f - 2.0f / (e + 1.0f)); }
struct EpiMlIn {
    bf16 *MQ, *MK, *MV, *MO; float *IG, *LF; const float *bi, *bf_;
    __device__ __forceinline__ void prefetch(pg8::EpiPre&, const pg8::Unit&, int, int, int, int) const {}
    __device__ __forceinline__ void operator()(const f32x4 (&acc)[2][2][4][2], const pg8::Unit& u, int wr, int wc, int fr, int fq, const pg8::EpiPre&) const {
        const int row0 = u.pm * 256 + wr * 64 + fr;
        if (u.pn < 12) {
            bf16* base; int ld, colt; float sc = 1.0f; const bool sg = u.pn >= 8;
            if (u.pn < 2) { base = MQ; ld = 512; colt = u.pn * 256; }
            else if (u.pn < 4) { base = MK; ld = 512; colt = (u.pn - 2) * 256; sc = 0.125f; }
            else if (u.pn < 8) { base = MV; ld = 1024; colt = (u.pn - 4) * 256; }
            else { base = MO; ld = 1024; colt = (u.pn - 8) * 256; }
            const int col0 = colt + wc * 32 + 8 * fq;
#pragma unroll
            for (int ai = 0; ai < 2; ++ai)
#pragma unroll
                for (int m = 0; m < 4; ++m) { bf16* rowp = base + (size_t)(row0 + ai * 128 + m * 16) * ld + col0;
#pragma unroll
                    for (int bj = 0; bj < 2; ++bj) { f32x4 v0 = acc[ai][bj][m][0] * sc, v1 = acc[ai][bj][m][1] * sc;
                        if (sg) {
#pragma unroll
                            for (int j = 0; j < 4; ++j) { v0[j] = sigmoidf_(v0[j]); v1[j] = sigmoidf_(v1[j]); } }
                        v4u w; w.x = cvt_pk_bf16(v0[0], v0[1]); w.y = cvt_pk_bf16(v0[2], v0[3]); w.z = cvt_pk_bf16(v1[0], v1[1]); w.w = cvt_pk_bf16(v1[2], v1[3]);
                        *(v4u*)(rowp + bj * 128) = w; } }
        } else if (wc == 0 && fq < 2) {
            const float* bb = fq == 0 ? bi : bf_; float* dst = fq == 0 ? IG : LF;
            const f32x4 b0 = *(const f32x4*)bb, b1 = *(const f32x4*)(bb + 4);
#pragma unroll
            for (int ai = 0; ai < 2; ++ai)
#pragma unroll
                for (int m = 0; m < 4; ++m) { const size_t row = (size_t)(row0 + ai * 128 + m * 16);
                    f32x4 v0 = acc[ai][0][m][0] + b0, v1 = acc[ai][0][m][1] + b1;
#pragma unroll
                    for (int j = 0; j < 4; ++j) { float z0 = softcap15(v0[j]), z1 = softcap15(v1[j]);
                        if (fq == 1) { z0 = fminf(z0, 0.f) - log1pf(__expf(-fabsf(z0))); z1 = fminf(z1, 0.f) - log1pf(__expf(-fabsf(z1))); }
                        v0[j] = z0; v1[j] = z1; }
                    *(f32x4*)(dst + row * 8) = v0; *(f32x4*)(dst + row * 8 + 4) = v1; }
        }
    }
};
struct EpiSwiglu {
    unsigned char* ACT; const float* bias;
    __device__ __forceinline__ void prefetch(pg8::EpiPre&, const pg8::Unit&, int, int, int, int) const {}
    __device__ __forceinline__ void operator()(const f32x4 (&acc)[2][2][4][2], const pg8::Unit& u, int wr, int wc, int fr, int fq, const pg8::EpiPre&) const {
        const int row0 = u.pm * 256 + wr * 64 + fr, cc = wc * 32 + 8 * fq;
        const float* bp = bias + (size_t)u.e * 2048 + u.pn * 256 + cc;
        f32x4 bg[2], bl[2];
#pragma unroll
        for (int n = 0; n < 2; ++n) { bg[n] = *(const f32x4*)(bp + 4 * n); bl[n] = *(const f32x4*)(bp + 128 + 4 * n); }
#pragma unroll
        for (int ai = 0; ai < 2; ++ai)
#pragma unroll
            for (int m = 0; m < 4; ++m) { float a[8];
#pragma unroll
                for (int n = 0; n < 2; ++n) { const f32x4 gl = acc[ai][0][m][n] * WSCALE_INV + bg[n], li = acc[ai][1][m][n] * WSCALE_INV + bl[n];
#pragma unroll
                    for (int j = 0; j < 4; ++j) { const float gg = fminf(gl[j], 7.0f), ll = fminf(fmaxf(li[j], -7.0f), 7.0f); a[4 * n + j] = gg * sigmoidf_(1.702f * gg) * (ll + 1.0f); } }
                *(v2u*)(ACT + (size_t)(row0 + ai * 128 + m * 16) * 1024 + u.pn * 128 + cc) = pack8_fp8(a); }
    }
};
struct EpiDown {
    unsigned char* Y; const float* bias;
    __device__ __forceinline__ void prefetch(pg8::EpiPre& p, const pg8::Unit& u, int wr, int wc, int fr, int fq) const {
        const float* bp = bias + (size_t)u.e * 1024 + u.pn * 256 + wc * 32 + 8 * fq;
#pragma unroll
        for (int bj = 0; bj < 2; ++bj)
#pragma unroll
            for (int n = 0; n < 2; ++n) p.v[2 * bj + n] = *(const f32x4*)(bp + bj * 128 + 4 * n);
    }
    __device__ __forceinline__ void operator()(const f32x4 (&acc)[2][2][4][2], const pg8::Unit& u, int wr, int wc, int fr, int fq, const pg8::EpiPre& pre) const {
        const int row0 = u.pm * 256 + wr * 64 + fr, col0 = u.pn * 256 + wc * 32 + 8 * fq;
#pragma unroll
        for (int ai = 0; ai < 2; ++ai)
#pragma unroll
            for (int m = 0; m < 4; ++m) { unsigned char* rowp = Y + (size_t)(row0 + ai * 128 + m * 16) * 1024 + col0;
#pragma unroll
                for (int bj = 0; bj < 2; ++bj) { const f32x4 v0 = acc[ai][bj][m][0] * WSCALE_INV + pre.v[2 * bj], v1 = acc[ai][bj][m][1] * WSCALE_INV + pre.v[2 * bj + 1];
                    const float y8[8] = {v0[0], v0[1], v0[2], v0[3], v1[0], v1[1], v1[2], v1[3]};
                    *(v2u*)(rowp + bj * 128) = pack8_fp8(y8); } }
    }
};

template <bool GATHER_> struct MoeSched {
    static constexpr bool GATHER = GATHER_;
    const LAS int* cnt; const LAS int* tstart; const LAS int* tile_e; const int* list; int NN, NB_, G, c;
    __device__ __forceinline__ bool next(int i, pg8::Unit& u) const {
        const int MT = __builtin_amdgcn_readfirstlane(tstart[32]);
        int L = i * G + c;
        if (G % (8 * NN) == 0) { const int x = c & 7, j = c >> 3, mpx = G / (8 * NN); L = i * G + (x * mpx + j / NN) * NN + j % NN; }
        if (L >= MT * NN) return false;
        u.pm = L / NN; u.pn = L % NN; u.e = __builtin_amdgcn_readfirstlane(tile_e[u.pm]); return true;
    }
    __device__ __forceinline__ unsigned a_row(const pg8::Unit& u, int r) const {
        if (!GATHER_) return (unsigned)(u.pm * 256 + r);
        int pos = (u.pm - tstart[u.e]) * 256 + r; const int n = cnt[u.e]; pos = pos < n ? pos : n - 1;
        return (unsigned)(list[u.e * T + pos] >> 2);
    }
    __device__ __forceinline__ unsigned b_row0(const pg8::Unit& u) const { return (unsigned)(u.e * NB_ + u.pn * 256); }
};

struct Ctx { LAS unsigned char* lds; int tid, lane, wave, G, bid; };

template <class RowMap>
__device__ __forceinline__ void transpose_item(const float* W, int N, bf16* WT, LAS float* scr, int item, int lane, const RowMap& rm) {
    const int nblk = (N + 31) / 32, kb = item / nblk, nb = item % nblk, k0 = 64 * kb, n0 = 32 * nb;
    const int nc = n0 + (lane & 31); const bool ok = nc < N;
#pragma unroll 16
    for (int i = 0; i < 32; ++i) { const int kk = 2 * i + (lane >> 5); scr[kk * 33 + (lane & 31)] = ok ? W[(size_t)(k0 + kk) * N + nc] : 0.f; }
    LDS_WAIT(); asm volatile("" ::: "memory");
    const int c = lane & 7;
#pragma unroll
    for (int j = 0; j < 4; ++j) { const int n = (lane >> 3) + 8 * j; const LAS float* s = scr + (8 * c) * 33 + n;
        v4u o; o.x = cvt_pk_bf16(s[0 * 33], s[1 * 33]); o.y = cvt_pk_bf16(s[2 * 33], s[3 * 33]); o.z = cvt_pk_bf16(s[4 * 33], s[5 * 33]); o.w = cvt_pk_bf16(s[6 * 33], s[7 * 33]);
        *(GAS v4u*)(WT + (size_t)rm(n0 + n) * 1024 + k0 + 8 * c) = o; }
    LDS_WAIT(); asm volatile("" ::: "memory");
}
template <class RowMap>
__device__ __forceinline__ void transpose_item_f8(const float* W, int N, unsigned char* WT, LAS float* scr, int item, int lane, const RowMap& rm) {
    const int nblk = N / 32, kb = item / nblk, nb = item % nblk, k0 = 64 * kb, n0 = 32 * nb;
#pragma unroll 16
    for (int i = 0; i < 32; ++i) { const int kk = 2 * i + (lane >> 5); scr[kk * 33 + (lane & 31)] = W[(size_t)(k0 + kk) * N + n0 + (lane & 31)]; }
    LDS_WAIT(); asm volatile("" ::: "memory");
    const int c = lane & 7;
#pragma unroll
    for (int j = 0; j < 4; ++j) { const int n = (lane >> 3) + 8 * j; const LAS float* sp = scr + (8 * c) * 33 + n; float x[8];
#pragma unroll
        for (int q = 0; q < 8; ++q) x[q] = sp[q * 33] * WSCALE;
        *(GAS v2u*)(WT + (size_t)rm(n0 + n) * 1024 + k0 + 8 * c) = pack8_fp8(x); }
    LDS_WAIT(); asm volatile("" ::: "memory");
}
struct CvtItem { const float* W; unsigned char* WT; int N, isgu, rowoff, k0, n0; };
__device__ __forceinline__ CvtItem cvt_decode(int it, const float* WGUf, const float* WDNf, unsigned char* Wgu8, unsigned char* Wdn8) {
    constexpr int IGU = 16 * 64, IDN = 16 * 32; CvtItem c;
    if (it < 64 * IGU) { const int le = it / IGU, r = it % IGU; c.W = WGUf + (size_t)le * 1024 * 2048; c.WT = Wgu8; c.N = 2048; c.isgu = 1; c.rowoff = le * 2048; c.k0 = 64 * (r / 64); c.n0 = 32 * (r % 64); }
    else { const int q = it - 64 * IGU, le = q / IDN, r = q % IDN; c.W = WDNf + (size_t)le * 1024 * 1024; c.WT = Wdn8; c.N = 1024; c.isgu = 0; c.rowoff = le * 1024; c.k0 = 64 * (r / 32); c.n0 = 32 * (r % 32); }
    return c;
}
__device__ __forceinline__ void cvt_load(const CvtItem& c, int lane, float (&r)[32]) {
    const float* p = c.W + (size_t)(c.k0 + (lane >> 5)) * c.N + c.n0 + (lane & 31);
#pragma unroll
    for (int i = 0; i < 32; ++i) r[i] = __builtin_nontemporal_load(p + (size_t)(2 * i) * c.N);
}
__device__ __forceinline__ void cvt_finish(const CvtItem& c, int lane, const float (&r)[32], LAS float* scr) {
#pragma unroll
    for (int i = 0; i < 32; ++i) scr[(2 * i + (lane >> 5)) * 33 + (lane & 31)] = r[i];
    LDS_WAIT(); asm volatile("" ::: "memory");
    const int cc = lane & 7;
#pragma unroll
    for (int j = 0; j < 4; ++j) { const int n = (lane >> 3) + 8 * j; const LAS float* sp = scr + (8 * cc) * 33 + n; float x[8];
#pragma unroll
        for (int q = 0; q < 8; ++q) x[q] = sp[q * 33] * WSCALE;
        const int L = c.n0 + n; int prow;
        if (c.isgu) { const int jj_ = L >> 1, bj = L & 1; prow = c.rowoff + 256 * (jj_ >> 7) + 128 * bj + (jj_ & 127); } else prow = c.rowoff + L;
        *(GAS v2u*)(c.WT + (size_t)prow * 1024 + c.k0 + 8 * cc) = pack8_fp8(x); }
    LDS_WAIT(); asm volatile("" ::: "memory");
}
struct RmId { int off; __device__ __forceinline__ int operator()(int n) const { return off + n; } };
struct RmQK { __device__ __forceinline__ int operator()(int n) const { if (n >= 2048) return n; const int b = n >> 5, pn = b >> 3, wc = (b >> 1) & 3, bj = b & 1; return (pn * 8 + bj * 4 + wc) * 32 + (n & 31); } };
struct RmGU { int off; __device__ __forceinline__ int operator()(int n) const { const int j = n >> 1, bj = n & 1, pn = j >> 7, jj = j & 127; return off + 256 * pn + 128 * bj + jj; } };

__device__ __forceinline__ void norm_row_store_f8(const f32x4 (&v)[4], const float* gain, const float* sc, const float* sh, unsigned char* orow, int lane) {
    float ss = 0.f;
#pragma unroll
    for (int j = 0; j < 4; ++j) ss += (v[j][0] * v[j][0] + v[j][1] * v[j][1]) + (v[j][2] * v[j][2] + v[j][3] * v[j][3]);
    const float rs = rsqrtf(wave_sum(ss) * (1.0f / 1024.0f) + RMS_EPS);
#pragma unroll
    for (int j = 0; j < 4; ++j) { const int c = 4 * lane + 256 * j;
        const f32x4 g = *(const f32x4*)(gain + c), s = *(const f32x4*)(sc + c), h = *(const f32x4*)(sh + c);
        const f32x4 o = v[j] * rs * g * (s + 1.0f) + h;
        int w = 0; w = __builtin_amdgcn_cvt_pk_fp8_f32(o[0], o[1], w, false); w = __builtin_amdgcn_cvt_pk_fp8_f32(o[2], o[3], w, true);
        *(int*)(orow + c) = w; }
}
__device__ __forceinline__ void norm_row_store(const f32x4 (&v)[4], const float* gain, const float* sc, const float* sh, bf16* orow, int lane) {
    float ss = 0.f;
#pragma unroll
    for (int j = 0; j < 4; ++j) ss += (v[j][0] * v[j][0] + v[j][1] * v[j][1]) + (v[j][2] * v[j][2] + v[j][3] * v[j][3]);
    const float rs = rsqrtf(wave_sum(ss) * (1.0f / 1024.0f) + RMS_EPS);
#pragma unroll
    for (int j = 0; j < 4; ++j) { const int c = 4 * lane + 256 * j;
        const f32x4 g = *(const f32x4*)(gain + c), s = *(const f32x4*)(sc + c), h = *(const f32x4*)(sh + c);
        const f32x4 o = v[j] * rs * g * (s + 1.0f) + h;
        v2u w; w.x = cvt_pk_bf16(o[0], o[1]); w.y = cvt_pk_bf16(o[2], o[3]);
        *(v2u*)(orow + c) = w; }
}


#define ML_BAR() asm volatile("s_waitcnt lgkmcnt(0)\n\ts_barrier" ::: "memory")
template <bool FULL>
__device__ __forceinline__ void mlstm_stream(LAS unsigned char* ldsp, unsigned char* ws, const float* ogain, int b, int h, int cbeg, int nch, int tid, int lane, int wave,
                                             f32x16& CT, float& gsum, float& nreg) {
    const bf16 *MQ_ = (const bf16*)(ws + WS_MQ), *MK_ = (const bf16*)(ws + WS_MK), *MV_ = (const bf16*)(ws + WS_MV), *MO_ = (const bf16*)(ws + WS_MO);
    const float *IG_ = (const float*)(ws + WS_IG), *LF_ = (const float*)(ws + WS_LF); bf16* ATTC_ = (bf16*)(ws + WS_ATTC);
    constexpr int QS = 72, A2S = 136, HS = 132;
    LAS bf16* Qn = (LAS bf16*)ldsp;
    LAS bf16* Kn = Qn + 64 * QS;
    LAS bf16* Kwt = Kn + 64 * QS;
    LAS bf16* A2 = Kwt + 64 * QS;
    LAS bf16* B2t = A2 + 64 * A2S;
    LAS float* Hout = (LAS float*)(B2t + 128 * A2S);
    LAS float* vec = Hout + 64 * HS;
    LAS float *v_u = vec, *v_w = vec + 64, *v_eb = vec + 128, *v_dp0 = vec + 192, *v_dp1 = vec + 256, *v_di = vec + 320, *v_n = vec + 384;
    const int r32 = lane & 31, hi = lane >> 5, row = 8 * wave + (lane >> 3), ch = lane & 7, tsw = ((wave ^ ch) << 3) + (lane >> 3);
    const int hrow = wave * 8 + (lane >> 3), hpart = lane & 7;
    LAS float* v_gn = vec + 448;
    if (FULL) {
#pragma unroll
        for (int j = 0; j < 4; ++j) *(LAS f32x4*)(v_gn + 16 * hpart + 4 * j) = *(const f32x4*)(ogain + h * 128 + 16 * hpart + 4 * j);
        const int vb = wave >> 1, db = wave & 1;
#pragma unroll
        for (int r = 0; r < 16; ++r) { const int v = 32 * vb + (r & 3) + 8 * (r >> 2) + 4 * hi; B2t[v * A2S + 64 + 32 * db + r32] = (bf16)(cvt_pk_bf16(CT[r], 0.f) & 0xffffu); }
        if (wave == 3) v_n[lane] = nreg; }
    v4u pq = {0u, 0u, 0u, 0u}, pk, pv0, pv1, pog0 = {0u, 0u, 0u, 0u}, pog1 = {0u, 0u, 0u, 0u}; float pig, plf;
#define ML_LOAD(cc) do { const size_t t0_ = (size_t)b * SEQ + (size_t)(cc) * 64; \
        if (FULL) pq = *(const v4u*)(MQ_ + (t0_ + row) * 512 + h * 64 + 8 * ch); \
        pk = *(const v4u*)(MK_ + (t0_ + row) * 512 + h * 64 + 8 * ch); \
        pv0 = *(const v4u*)(MV_ + (t0_ + row) * 1024 + h * 128 + 8 * ch); pv1 = *(const v4u*)(MV_ + (t0_ + row) * 1024 + h * 128 + 8 * (ch + 8)); \
        pig = IG_[(t0_ + lane) * 8 + h]; plf = LF_[(t0_ + lane) * 8 + h]; \
        if (FULL) { pog0 = *(const v4u*)(MO_ + (t0_ + hrow) * 1024 + h * 128 + 16 * hpart); pog1 = *(const v4u*)(MO_ + (t0_ + hrow) * 1024 + h * 128 + 16 * hpart + 8); } } while (0)
    ML_LOAD(cbeg);
    ML_BAR();
    for (int c = cbeg; c < cbeg + nch; ++c) {
        const size_t t0 = (size_t)b * SEQ + (size_t)c * 64;
        float bcs = plf;
        bcs += dppf<0x111, 0xf>(bcs); bcs += dppf<0x112, 0xf>(bcs); bcs += dppf<0x114, 0xf>(bcs); bcs += dppf<0x118, 0xf>(bcs);
        bcs += dppf<0x142, 0xa>(bcs); bcs += dppf<0x143, 0xc>(bcs);
        const float g = __int_as_float(__builtin_amdgcn_readlane(__float_as_int(bcs), 63)), ig = pig, eb = __expf(bcs), wk = __expf(g - bcs + ig), eg = __expf(g);
        gsum += g;
        const float wk_r = __shfl(wk, row), eb_r = __shfl(eb, row);
        v4u ogc0 = pog0, ogc1 = pog1;
        if (FULL) {
            v_u[lane] = bcs * 1.4426950408889634f; v_w[lane] = (bcs - ig) * 1.4426950408889634f; v_eb[lane] = eb; v_dp1[lane] = 0.f;
            *(LAS v4u*)(Qn + row * QS + 8 * ch) = pq; *(LAS v4u*)(Kn + row * QS + 8 * ch) = pk;
            v4u o;
#pragma unroll
            for (int j = 0; j < 4; ++j) o[j] = cvt_pk_bf16(bf_lo(pq[j]) * eb_r, bf_hi(pq[j]) * eb_r);
            *(LAS v4u*)(A2 + row * A2S + 64 + 8 * ch) = o;
        }
#pragma unroll
        for (int j = 0; j < 4; ++j) { const unsigned a = cvt_pk_bf16(bf_lo(pk[j]) * wk_r, bf_hi(pk[j]) * wk_r);
            Kwt[(8 * ch + 2 * j) * QS + tsw] = (bf16)(a & 0xffffu); Kwt[(8 * ch + 2 * j + 1) * QS + tsw] = (bf16)(a >> 16);
            B2t[(8 * ch + 2 * j) * A2S + tsw] = (bf16)(pv0[j] & 0xffffu); B2t[(8 * ch + 2 * j + 1) * A2S + tsw] = (bf16)(pv0[j] >> 16);
            B2t[(8 * (ch + 8) + 2 * j) * A2S + tsw] = (bf16)(pv1[j] & 0xffffu); B2t[(8 * (ch + 8) + 2 * j + 1) * A2S + tsw] = (bf16)(pv1[j] >> 16); }
        if (c + 1 < cbeg + nch) ML_LOAD(c + 1);
        ML_BAR();
        if (FULL) {
            if (wave < 3) {
                const int sb = wave == 2 ? 1 : 0, lb = wave == 0 ? 0 : 1;
                f32x16 p;
#pragma unroll
                for (int r = 0; r < 16; ++r) p[r] = 0.f;
#pragma unroll
                for (int kk = 0; kk < 4; ++kk) { const bf16x8 af = *(const LAS bf16x8*)(Kn + (32 * sb + r32) * QS + 16 * kk + 8 * hi), bfr = *(const LAS bf16x8*)(Qn + (32 * lb + r32) * QS + 16 * kk + 8 * hi);
                    p = __builtin_amdgcn_mfma_f32_32x32x16_bf16(af, bfr, p, 0, 0, 0); }
                const int l = 32 * lb + r32; const float ul = v_u[l]; float dsum = 0.f;
#pragma unroll
                for (int r = 0; r < 16; ++r) { const int s_ = 32 * sb + (r & 3) + 8 * (r >> 2) + 4 * hi; const float dd = (s_ <= l) ? __builtin_amdgcn_exp2f(ul - v_w[s_]) : 0.f; p[r] *= dd; dsum += p[r]; }
                { const unsigned u_ = __float_as_uint(dsum); auto r_ = __builtin_amdgcn_permlane32_swap(u_, u_, false, false); dsum = __uint_as_float(r_[0]) + __uint_as_float(r_[1]); }
                if (hi == 0) { if (sb == 0) v_dp0[l] = dsum; else v_dp1[l] = dsum; }
#pragma unroll
                for (int g4 = 0; g4 < 4; ++g4) { v2u w; w.x = cvt_pk_bf16(p[4 * g4], p[4 * g4 + 1]); w.y = cvt_pk_bf16(p[4 * g4 + 2], p[4 * g4 + 3]);
                    *(LAS v2u*)(A2 + l * A2S + 32 * sb + 8 * g4 + 4 * hi) = w; }
            } else if (wave == 3) {
                for (int i = lane; i < 32 * 16; i += 64) { const int l = i >> 4, c2 = i & 15; *(LAS unsigned*)(A2 + l * A2S + 32 + 2 * c2) = 0u; }
            } else if (wave == 4) {
                float s0 = 0.f, s1 = 0.f, s2 = 0.f, s3 = 0.f;
#pragma unroll 2
                for (int d8 = 0; d8 < 8; ++d8) { const v4u qv = *(const LAS v4u*)(Qn + lane * QS + 8 * d8); const f32x4 n0 = *(const LAS f32x4*)(v_n + 8 * d8), n1 = *(const LAS f32x4*)(v_n + 8 * d8 + 4);
                    s0 += bf_lo(qv.x) * n0[0]; s1 += bf_hi(qv.x) * n0[1]; s2 += bf_lo(qv.y) * n0[2]; s3 += bf_hi(qv.y) * n0[3];
                    s0 += bf_lo(qv.z) * n1[0]; s1 += bf_hi(qv.z) * n1[1]; s2 += bf_lo(qv.w) * n1[2]; s3 += bf_hi(qv.w) * n1[3]; }
                v_di[lane] = ((s0 + s1) + (s2 + s3)) * eb;
            }
            ML_BAR();
            {
                const int lb = wave >> 2, vb = wave & 3;
                f32x16 nm;
#pragma unroll
                for (int r = 0; r < 16; ++r) nm[r] = 0.f;
#pragma unroll
                for (int kk = 0; kk < 8; ++kk) { const bf16x8 af = *(const LAS bf16x8*)(A2 + (32 * lb + r32) * A2S + 16 * kk + 8 * hi), bfr = *(const LAS bf16x8*)(B2t + (32 * vb + r32) * A2S + (kk < 4 ? (((2 * kk + hi) ^ ((4 * vb + (r32 >> 3)) & 7)) << 3) : 16 * kk + 8 * hi));
                    nm = __builtin_amdgcn_mfma_f32_32x32x16_bf16(af, bfr, nm, 0, 0, 0); }
#pragma unroll
                for (int r = 0; r < 16; ++r) { const int l = 32 * lb + (r & 3) + 8 * (r >> 2) + 4 * hi; const float den = v_dp0[l] + v_dp1[l] + v_di[l];
                    Hout[l * HS + 32 * vb + r32] = nm[r] * __builtin_amdgcn_rcpf(fmaxf(fabsf(den), 1.0f)); }
            }
        }
        {
            const int vb = wave >> 1, db = wave & 1;
#pragma unroll
            for (int r = 0; r < 16; ++r) CT[r] *= eg;
#pragma unroll
            for (int kk = 0; kk < 4; ++kk) { const bf16x8 af = *(const LAS bf16x8*)(B2t + (32 * vb + r32) * A2S + (((2 * kk + hi) ^ ((4 * vb + (r32 >> 3)) & 7)) << 3)), bfr = *(const LAS bf16x8*)(Kwt + (32 * db + r32) * QS + (((2 * kk + hi) ^ ((4 * db + (r32 >> 3)) & 7)) << 3));
                CT = __builtin_amdgcn_mfma_f32_32x32x16_bf16(af, bfr, CT, 0, 0, 0); }
            if (wave == 3) { float s0 = 0.f, s1 = 0.f, s2 = 0.f, s3 = 0.f;
#pragma unroll 2
                for (int l8 = 0; l8 < 8; ++l8) { const v4u kv = *(const LAS v4u*)(Kwt + lane * QS + 8 * l8);
                    s0 += bf_lo(kv.x) + bf_hi(kv.x); s1 += bf_lo(kv.y) + bf_hi(kv.y); s2 += bf_lo(kv.z) + bf_hi(kv.z); s3 += bf_lo(kv.w) + bf_hi(kv.w); }
                nreg = eg * nreg + ((s0 + s1) + (s2 + s3)); }
        }
        ML_BAR();
        if (FULL) {
            const int vb = wave >> 1, db = wave & 1;
#pragma unroll
            for (int r = 0; r < 16; ++r) { const int v = 32 * vb + (r & 3) + 8 * (r >> 2) + 4 * hi; B2t[v * A2S + 64 + 32 * db + r32] = (bf16)(cvt_pk_bf16(CT[r], 0.f) & 0xffffu); }
            if (wave == 3) v_n[lane] = nreg;
            {
                f32x4 hv[4]; float ss = 0.f;
#pragma unroll
                for (int j = 0; j < 4; ++j) { hv[j] = *(const LAS f32x4*)(Hout + hrow * HS + 16 * hpart + 4 * j); ss += (hv[j][0] * hv[j][0] + hv[j][1] * hv[j][1]) + (hv[j][2] * hv[j][2] + hv[j][3] * hv[j][3]); }
                ss = sum_lanes8(ss);
                const float rs = rsqrtf(ss * (1.0f / 128.0f) + RMS_EPS);
                v4u w0, w1;
#pragma unroll
                for (int j = 0; j < 2; ++j) { const f32x4 y = hv[j] * rs * *(const LAS f32x4*)(v_gn + 16 * hpart + 4 * j); w0[2 * j] = cvt_pk_bf16(y[0] * bf_lo(ogc0[2 * j]), y[1] * bf_hi(ogc0[2 * j])); w0[2 * j + 1] = cvt_pk_bf16(y[2] * bf_lo(ogc0[2 * j + 1]), y[3] * bf_hi(ogc0[2 * j + 1])); }
#pragma unroll
                for (int j = 0; j < 2; ++j) { const f32x4 y = hv[2 + j] * rs * *(const LAS f32x4*)(v_gn + 16 * hpart + 4 * (2 + j)); w1[2 * j] = cvt_pk_bf16(y[0] * bf_lo(ogc1[2 * j]), y[1] * bf_hi(ogc1[2 * j])); w1[2 * j + 1] = cvt_pk_bf16(y[2] * bf_lo(ogc1[2 * j + 1]), y[3] * bf_hi(ogc1[2 * j + 1])); }
                bf16* dst = ATTC_ + (t0 + hrow) * 1024 + h * 128 + 16 * hpart;
                *(v4u*)dst = w0; *(v4u*)(dst + 8) = w1;
            }
        }
    }
    ML_BAR();
#undef ML_LOAD
}

#ifndef PHMASK
#define PHMASK 0xffffffffu
#endif
#define PH(n) (((PHMASK) >> (n)) & 1u)
#ifndef REPMASK
#define REPMASK 0u
#endif
#define REPS(n) (1 + (int)(((REPMASK) >> (n)) & 1u))
__global__ void __launch_bounds__(512, 2) fwd(Params P) {
    extern __shared__ __attribute__((aligned(16))) unsigned char lds_raw[];
    LAS unsigned char* lds = (LAS unsigned char*)lds_raw;
    const int G = gridDim.x, bid = blockIdx.x, NGW = G * 8;
    for (int u = threadIdx.x; u < (LDS_BYTES - LDSCTL_OFF) / 4; u += 512) ((LAS unsigned*)(lds + LDSCTL_OFF))[u] = 0u;
    __syncthreads();
typedef const __attribute__((address_space(4))) Params* CParamsPtr;
#define BAR_OBJ(b_) XcdBarrier b_; { CParamsPtr pq_ = (CParamsPtr)__builtin_amdgcn_kernarg_segment_ptr(); asm volatile("" : "+s"(pq_)); b_.bar = (unsigned*)(pq_->ws + WS_CTL) + CW_BAR; b_.x = xb_xcc_id(); \
    b_.st = (volatile LAS unsigned*)(lds + LDSCTL_OFF + LT_MISC) + 8; }
    { BAR_OBJ(b0_); if (threadIdx.x == 0) (void)xb_add(&b0_.bar[XB_XCNT(b0_.x)], 1u); }
#define GRID_BAR() do { BAR_OBJ(bb_); xcd_barrier(bb_); } while (0)
#define PH_BEGIN CParamsPtr pp = (CParamsPtr)__builtin_amdgcn_kernarg_segment_ptr(); asm volatile("" : "+s"(pp)); unsigned char* const ws = pp->ws; \
    int tid_o = threadIdx.x; asm volatile("" : "+v"(tid_o)); const int tid = tid_o, lane = tid & 63, wave = __builtin_amdgcn_readfirstlane(tid >> 6), gw = bid * 8 + wave; (void)gw; (void)lane; (void)ws; \
    int ldso_ = 0; asm volatile("" : "+s"(ldso_)); LAS unsigned char* const ldsp = (LAS unsigned char*)(size_t)(unsigned)ldso_; (void)ldsp;
#define Lcnt ((LAS int*)(ldsp + LDSCTL_OFF + LT_CNT))
#define Ltstart ((LAS int*)(ldsp + LDSCTL_OFF + LT_TSTART))
#define Ltilee ((LAS int*)(ldsp + LDSCTL_OFF + LT_TILEE))
#define ctl ((unsigned*)(ws + WS_CTL))
#define modF ((float*)(ws + WS_MODF))
#define lamp ((float*)(ws + WS_LAM))
#define bgup ((float*)(ws + WS_BGUP))
#define rwt ((bf16*)(ws + WS_RWT))
#define rope ((float*)(ws + WS_ROPE))
#define Wqkv ((bf16*)(ws + WS_WQKV))
#define Wo ((bf16*)(ws + WS_WO))
#define Wml ((bf16*)(ws + WS_WML))
#define Wmlo ((bf16*)(ws + WS_WMLO))
#define toke ((int*)(ws + WS_TOKE))
#define gatew ((float*)(ws + WS_GATE))
#define list ((int*)(ws + WS_LIST))
#define IG ((float*)(ws + WS_IG))
#define LF ((float*)(ws + WS_LF))
#define Wgu ((bf16*)(ws + WS_WGU))
#define Wdn ((bf16*)(ws + WS_WDN))
#define Hb ((bf16*)(ws + WS_H))
#define Qb ((bf16*)(ws + WS_Q))
#define Kb ((bf16*)(ws + WS_K))
#define Vb ((bf16*)(ws + WS_V))
#define MQ ((bf16*)(ws + WS_MQ))
#define MK ((bf16*)(ws + WS_MK))
#define MV ((bf16*)(ws + WS_MV))
#define MO ((bf16*)(ws + WS_MO))
#define OB ((bf16*)(ws + WS_OB))
#define ATTC ((bf16*)(ws + WS_ATTC))
#define X1 ((bf16*)(ws + WS_X1))
#define X2 ((bf16*)(ws + WS_X2))
#define ACT ((bf16*)(ws + WS_ACT))
#define Yb ((bf16*)(ws + WS_Y))
#define mdL (modF + (size_t)layer * 8 * 6144)

    if (PH(0)) { PH_BEGIN
        if (bid < 192) {
            LAS float* cact = (LAS float*)lds; LAS float* red = cact + 8192;
            for (int i = tid; i < 8192; i += 512) { const float v = pp->in[I_C][i]; cact[i] = v / (1.0f + __expf(-v)); }
            __syncthreads();
            const int col0 = bid * 64, layer = col0 / 6144, cc = col0 % 6144;
            const float* W = pp->in[I_ADAW] + (size_t)layer * 1024 * 6144 + cc + lane;
            float a[8];
#pragma unroll
            for (int b = 0; b < 8; ++b) a[b] = 0.f;
#pragma unroll 8
            for (int k = wave * 128; k < wave * 128 + 128; ++k) { const float w = W[(size_t)k * 6144];
#pragma unroll
                for (int b = 0; b < 8; ++b) a[b] += cact[b * 1024 + k] * w; }
#pragma unroll
            for (int b = 0; b < 8; ++b) red[(wave * 8 + b) * 64 + lane] = a[b];
            __syncthreads();
            { const int b = tid >> 6, l = tid & 63; float s = pp->in[I_ADAB][layer * 6144 + cc + l];
#pragma unroll
              for (int w = 0; w < 8; ++w) s += red[(w * 8 + b) * 64 + l];
              modF[(size_t)(layer * 8 + b) * 6144 + cc + l] = s; }
            __syncthreads();
        }
        for (int idx = bid * 512 + tid; idx < T * 32; idx += G * 512) { const int t = idx >> 5, i = idx & 31;
            const float ang = (float)((const int*)pp->in[I_POS])[t] * pp->invf[i];
            const double x = (double)ang * 0.15915494309189535; const float fr_ = (float)(x - rint(x));
            rope[(size_t)t * 64 + i] = __builtin_amdgcn_cosf(fr_); rope[(size_t)t * 64 + 32 + i] = __builtin_amdgcn_sinf(fr_); }
        if (bid == G - 1 && wave == 0) {
            const float s1 = wave_sum(pp->in[I_LQ1][lane] * pp->in[I_LK1][lane]), s2 = wave_sum(pp->in[I_LQ2][lane] * pp->in[I_LK2][lane]);
            if (lane == 0) lamp[0] = expf(s1) - expf(s2) + 0.2f;
        }
        for (int idx = bid * 512 + tid; idx < 2 * 1024 * 32; idx += G * 512) { const int layer = idx >> 15, k = (idx >> 5) & 1023, e = idx & 31;
            const float w = pp->in[I_RW][idx]; const unsigned hi = cvt_pk_bf16(w, 0.f) & 0xffffu; const float lo = w - bf_lo(hi);
            rwt[(size_t)(layer * 32 + e) * 1024 + k] = (bf16)hi; rwt[(size_t)(64 + layer * 32 + e) * 1024 + k] = (bf16)(cvt_pk_bf16(lo, 0.f) & 0xffffu); }
        for (int idx = bid * 512 + tid; idx < 2 * 32 * 2048; idx += G * 512) { const int n = idx & 2047, le = idx >> 11; const RmGU rm{0}; bgup[(size_t)le * 2048 + rm(n)] = pp->in[I_BGU][idx]; }
        LAS float* scr = (LAS float*)(lds + wave * 16384);
        constexpr int I_A = 16 * 96, I_B = 16 * 32, I_C2 = 16 * 97, I_D = 16 * 32;
        for (int it = gw; it < I_A + I_B + I_C2 + I_D; it += NGW) {
            int r = it;
            if (r < I_A) { transpose_item_f8(pp->in[I_AWIN], 3072, (unsigned char*)Wqkv, scr, r, lane, RmQK{}); continue; } r -= I_A;
            if (r < I_B) { transpose_item(pp->in[I_AWOUT], 1024, Wo, scr, r, lane, RmId{0}); continue; } r -= I_B;
            if (r < I_C2) { transpose_item(pp->in[I_MWIN], 3088, Wml, scr, r, lane, RmId{0}); continue; } r -= I_C2;
            transpose_item(pp->in[I_MWOUT], 1024, Wmlo, scr, r, lane, RmId{0});
        }
        for (int idx = bid * 512 + tid; idx < (MLN - 3104) * 1024 / 8; idx += G * 512) *(v4u*)(Wml + (size_t)3104 * 1024 + (size_t)idx * 8) = (v4u){0u, 0u, 0u, 0u};
        {
            constexpr int NIT = 64 * (16 * 64 + 16 * 32), PFXN = 11;
            const float* WGUf = pp->in[I_WGU]; const float* WDNf = pp->in[I_WDN]; unsigned char* Wgu8 = (unsigned char*)Wgu; unsigned char* Wdn8 = (unsigned char*)Wdn;
            const int nmw = G > 192 ? (G - 192) * 8 : 0, gwn = (bid - 192) * 8 + wave, pfx = nmw * PFXN; const bool nonmod = bid >= 192;
#define CVT_SEQ(j) (nonmod ? ((j) < PFXN ? gwn + (j) * nmw : pfx + gw + ((j) - PFXN) * NGW) : pfx + gw + (j) * NGW)
            float ra[32], rb[32];
            int j = 0, it = CVT_SEQ(0);
            if (it < NIT) { const CvtItem c0 = cvt_decode(it, WGUf, WDNf, Wgu8, Wdn8); cvt_load(c0, lane, ra); }
            for (; it < NIT; j += 2, it = CVT_SEQ(j)) {
                const CvtItem ca = cvt_decode(it, WGUf, WDNf, Wgu8, Wdn8);
                const int itb = CVT_SEQ(j + 1), itc = CVT_SEQ(j + 2);
                const bool hb = itb < NIT, hc = itc < NIT;
                if (hb) { const CvtItem cb = cvt_decode(itb, WGUf, WDNf, Wgu8, Wdn8); cvt_load(cb, lane, rb); }
                cvt_finish(ca, lane, ra, scr);
                if (hc) { const CvtItem cc = cvt_decode(itc, WGUf, WDNf, Wgu8, Wdn8); cvt_load(cc, lane, ra); }
                if (hb) { const CvtItem cb = cvt_decode(itb, WGUf, WDNf, Wgu8, Wdn8); cvt_finish(cb, lane, rb, scr); }
            }
#undef CVT_SEQ
        }
    }
    GRID_BAR();

    for (int rep_ = 0; rep_ < REPS(1); ++rep_) {
    if (PH(1)) { PH_BEGIN
        const float* x = pp->in[I_X];
        for (int m = gw; m < T; m += NGW) { const int b = m >> 12; const float* md = modF + (size_t)b * 6144;
            f32x4 v[4];
#pragma unroll
            for (int j = 0; j < 4; ++j) v[j] = __builtin_nontemporal_load((const f32x4*)(x + (size_t)m * 1024 + 4 * lane + 256 * j));
            norm_row_store_f8(v, pp->in[I_MIXN], md + 1024, md, (unsigned char*)Hb + (size_t)m * 1024, lane); }
    }
    GRID_BAR(); }

    for (int rep_ = 0; rep_ < REPS(2); ++rep_) {
    if (PH(2)) { PH_BEGIN
        pg8::DenseSched S; S.init(T, 3072, G, bid);
        EpiQKV<true> E{Qb, Kb, Vb, rope, pp->in[I_AQN], pp->in[I_AKN]};
        pg8::gemm_phase<EpiQKV<true>, pg8::DenseSched, true, true>(lds, Hb, Wqkv, S, E);
    }
    GRID_BAR(); }

    for (int rep_ = 0; rep_ < REPS(3); ++rep_) {
    if (PH(3)) { PH_BEGIN
        const int vcu = (G % 8 == 0) ? (bid % 8) * (G / 8) + bid / 8 : bid;
        const float lam = lamp[0];
        const f32x4 gA = *(const f32x4*)(pp->in[I_ASUB] + 8 * (lane & 15)) * 0.8f, gB = *(const f32x4*)(pp->in[I_ASUB] + 8 * (lane & 15) + 4) * 0.8f;
        for (int v2 = vcu; v2 < 256; v2 += G) {
            const int bh = v2 >> 2, c4 = v2 & 3;
            for (int i = 0; i < 8; ++i) { const int j = 4 * (i >> 1) + c4, qb = (i & 1) ? 31 - j : j;
                dattn::unit<8>(bh, qb, (const dattn::bf16h*)Qb, (const dattn::bf16h*)Kb, (const dattn::bf16h*)Vb, (dattn::bf16h*)ATTC, lam, gA, gB, (char*)lds_raw); }
        }
    }
    GRID_BAR(); }

    for (int layer = 0; layer < 2; ++layer) {
        if (layer == 1) {
            for (int rep_ = 0; rep_ < REPS(5); ++rep_) {
            if (PH(5)) { PH_BEGIN
                pg8::DenseSched S; S.init(T, 3072, G, bid);
                EpiMlIn E{MQ, MK, MV, MO, IG, LF, pp->in[I_MBI], pp->in[I_MBF]};
                pg8::gemm_phase<EpiMlIn, pg8::DenseSched, true>(lds, Hb, Wml, S, E);
                for (int tb = gw; tb < T / 16; tb += NGW) {
                    const int tk = lane & 15, kq = lane >> 4; const size_t tok = (size_t)tb * 16 + tk;
                    const bf16* ar = Hb + tok * 1024 + 8 * kq; const bf16* br = Wml + (size_t)(3072 + tk) * 1024 + 8 * kq;
                    f32x4 ga = {0.f, 0.f, 0.f, 0.f};
#pragma unroll 8
                    for (int s_ = 0; s_ < 32; ++s_) ga = __builtin_amdgcn_mfma_f32_16x16x32_bf16(*(const bf16x8*)(ar + 32 * s_), *(const bf16x8*)(br + 32 * s_), ga, 0, 0, 0);
                    const bool isf = tk >= 8; const float bb = isf ? pp->in[I_MBF][tk - 8] : pp->in[I_MBI][tk]; float* dst = isf ? LF : IG;
#pragma unroll
                    for (int r = 0; r < 4; ++r) { float z = softcap15(ga[r] + bb); if (isf) z = fminf(z, 0.f) - log1pf(__expf(-fabsf(z)));
                        dst[((size_t)tb * 16 + 4 * kq + r) * 8 + (tk & 7)] = z; }
                }
            }
            GRID_BAR(); }
            for (int rep_ = 0; rep_ < REPS(6); ++rep_) {
            if (PH(6)) { PH_BEGIN
                for (int u = bid; u < 256; u += G) { const int seg = u & 3; if (seg == 3) continue;
                    f32x16 CT; float gsum = 0.f, nreg = 0.f;
#pragma unroll
                    for (int r = 0; r < 16; ++r) CT[r] = 0.f;
                    mlstm_stream<false>(ldsp, ws, nullptr, u >> 5, (u >> 2) & 7, seg * 16, 16, tid, lane, wave, CT, gsum, nreg);
                    float* cts = (float*)(ws + WS_CTS) + (size_t)u * 8192;
#pragma unroll
                    for (int r = 0; r < 16; ++r) cts[(wave * 16 + r) * 64 + lane] = CT[r];
                    if (wave == 3) ((float*)(ws + WS_NS))[u * 64 + lane] = nreg;
                    if (tid == 0) ((float*)(ws + WS_GS))[u] = gsum;
                }
            }
            GRID_BAR(); }
            for (int rep_ = 0; rep_ < REPS(13); ++rep_) {
            if (PH(13)) { PH_BEGIN
                for (int u = bid; u < 256; u += G) { const int seg = u & 3;
                    f32x16 CT; float gsum = 0.f, nreg = 0.f;
#pragma unroll
                    for (int r = 0; r < 16; ++r) CT[r] = 0.f;
                    for (int sp = 0; sp < seg; ++sp) { const int up = (u & ~3) + sp; const float eg = __expf(((const float*)(ws + WS_GS))[up]);
                        const float* cts = (const float*)(ws + WS_CTS) + (size_t)up * 8192;
#pragma unroll
                        for (int r = 0; r < 16; ++r) CT[r] = CT[r] * eg + cts[(wave * 16 + r) * 64 + lane];
                        nreg = nreg * eg + ((const float*)(ws + WS_NS))[up * 64 + lane]; }
                    mlstm_stream<true>(ldsp, ws, pp->in[I_MON], u >> 5, (u >> 2) & 7, seg * 16, 16, tid, lane, wave, CT, gsum, nreg);
                }
            }
            GRID_BAR(); }
        }
        for (int rep_ = 0; rep_ < REPS(7); ++rep_) {
        if (PH(7)) { PH_BEGIN
            pg8::DenseSched S; S.init(T, 1024, G, bid);
            EpiResid E{pp->in[I_X], layer == 0 ? (const bf16*)nullptr : (const bf16*)X2, X1, mdL + 2048, (float*)(ws + WS_SSQ)};
            pg8::gemm_phase<EpiResid, pg8::DenseSched, true>(lds, ATTC, layer == 0 ? Wo : Wmlo, S, E);
        }
        GRID_BAR(); }
        if (PH(8)) { PH_BEGIN
            LAS unsigned char* rw = ldsp;
            LAS float* gsc = (LAS float*)(ldsp + LDSCTL_OFF + 4096); LAS float* shv = gsc + 1024;
            LAS float* lg = shv + 1024 + wave * (16 * 33);
            LAS int* hist = (LAS int*)(shv + 1024 + 8 * 16 * 33); LAS int* rec = hist + 32; LAS int* basee = rec + 512;
            const bf16* Whi = rwt + (size_t)layer * 32 * 1024; const bf16* Wlo = rwt + (size_t)(64 + layer * 32) * 1024;
            unsigned* gcnt = ctl + CW_CNT + layer * 32 * 16;
            for (int i = tid; i < 8192; i += 512) { const int r = i >> 7, c = i & 127;
                const v4u w = *(const v4u*)((r < 32 ? Whi + (size_t)r * 1024 : Wlo + (size_t)(r - 32) * 1024) + c * 8);
                *(LAS v4u*)(rw + r * 2048 + ((c ^ (r & 15)) << 4)) = w; }
            for (int blk = bid; blk < T / 128; blk += G) {
                const int b = blk >> 5; const float* md = mdL + (size_t)b * 6144;
                for (int i = tid; i < 1024; i += 512) { gsc[i] = pp->in[I_FFNN][layer * 1024 + i] * (1.0f + md[4 * 1024 + i]); shv[i] = md[3 * 1024 + i]; }
                if (tid < 32) hist[tid] = 0;
                __syncthreads();
                const int tk = lane & 15, kq = lane >> 4; const int tok = blk * 128 + wave * 16 + tk;
                const bf16* xr = X1 + (size_t)tok * 1024 + 8 * kq;
                float ss; { const f32x4 q4 = *(const f32x4*)((const float*)(ws + WS_SSQ) + (size_t)tok * 16 + 4 * kq); ss = (q4[0] + q4[1]) + (q4[2] + q4[3]); }
                ss = sum_fq4(ss);
                const float rs = rsqrtf(ss * (1.0f / 1024.0f) + RMS_EPS);
                f32x4 acc0 = {0.f, 0.f, 0.f, 0.f}, acc1 = {0.f, 0.f, 0.f, 0.f};
#pragma unroll 4
                for (int s = 0; s < 32; ++s) {
                    const int k0 = 32 * s + 8 * kq, sw = ((4 * s + kq) ^ tk) << 4;
                    const v4u xw = *(const v4u*)(xr + 32 * s);
                    const f32x4 a = {bf_lo(xw.x), bf_hi(xw.x), bf_lo(xw.y), bf_hi(xw.y)}, c = {bf_lo(xw.z), bf_hi(xw.z), bf_lo(xw.w), bf_hi(xw.w)};
                    const f32x4 g0 = *(const LAS f32x4*)(gsc + k0), g1 = *(const LAS f32x4*)(gsc + k0 + 4), h0 = *(const LAS f32x4*)(shv + k0), h1 = *(const LAS f32x4*)(shv + k0 + 4);
                    const f32x4 y0 = a * rs * g0 + h0, y1 = c * rs * g1 + h1;
                    v4u hw; hw.x = cvt_pk_bf16(y0[0], y0[1]); hw.y = cvt_pk_bf16(y0[2], y0[3]); hw.z = cvt_pk_bf16(y1[0], y1[1]); hw.w = cvt_pk_bf16(y1[2], y1[3]);
                    { const float y8[8] = {y0[0], y0[1], y0[2], y0[3], y1[0], y1[1], y1[2], y1[3]}; *(v2u*)((unsigned char*)Hb + (size_t)tok * 1024 + k0) = pack8_fp8(y8); }
                    v4u lw; lw.x = cvt_pk_bf16(y0[0] - bf_lo(hw.x), y0[1] - bf_hi(hw.x)); lw.y = cvt_pk_bf16(y0[2] - bf_lo(hw.y), y0[3] - bf_hi(hw.y));
                    lw.z = cvt_pk_bf16(y1[0] - bf_lo(hw.z), y1[1] - bf_hi(hw.z)); lw.w = cvt_pk_bf16(y1[2] - bf_lo(hw.w), y1[3] - bf_hi(hw.w));
                    const bf16x8 ah = __builtin_bit_cast(bf16x8, hw), al = __builtin_bit_cast(bf16x8, lw);
                    const bf16x8 wh0 = *(const LAS bf16x8*)(rw + tk * 2048 + sw), wh1 = *(const LAS bf16x8*)(rw + (16 + tk) * 2048 + sw);
                    const bf16x8 wl0 = *(const LAS bf16x8*)(rw + (32 + tk) * 2048 + sw), wl1 = *(const LAS bf16x8*)(rw + (48 + tk) * 2048 + sw);
                    acc0 = __builtin_amdgcn_mfma_f32_16x16x32_bf16(ah, wh0, acc0, 0, 0, 0); acc0 = __builtin_amdgcn_mfma_f32_16x16x32_bf16(al, wh0, acc0, 0, 0, 0); acc0 = __builtin_amdgcn_mfma_f32_16x16x32_bf16(ah, wl0, acc0, 0, 0, 0);
                    acc1 = __builtin_amdgcn_mfma_f32_16x16x32_bf16(ah, wh1, acc1, 0, 0, 0); acc1 = __builtin_amdgcn_mfma_f32_16x16x32_bf16(al, wh1, acc1, 0, 0, 0); acc1 = __builtin_amdgcn_mfma_f32_16x16x32_bf16(ah, wl1, acc1, 0, 0, 0);
                }
                { const float rb0 = pp->in[I_RB][layer * 32 + tk], rb1 = pp->in[I_RB][layer * 32 + 16 + tk];
#pragma unroll
                  for (int r = 0; r < 4; ++r) { lg[(4 * kq + r) * 33 + tk] = acc0[r] + rb0; lg[(4 * kq + r) * 33 + 16 + tk] = acc1[r] + rb1; } }
                LDS_WAIT(); asm volatile("" ::: "memory");
                if (lane < 16) {
                    const LAS float* row = lg + lane * 33; float tv[4]; int ti[4]; unsigned used = 0u;
#pragma unroll
                    for (int k = 0; k < 4; ++k) { float best = -INFINITY; int bi_ = 0;
                        for (int e = 0; e < 32; ++e) { const float v = row[e]; if (!((used >> e) & 1u) && v > best) { best = v; bi_ = e; } }
                        used |= 1u << bi_; tv[k] = best; ti[k] = bi_; }
                    float ex[4], sm = 0.f;
#pragma unroll
                    for (int k = 0; k < 4; ++k) { ex[k] = __expf(tv[k] - tv[0]); sm += ex[k]; }
                    const float inv = 1.0f / sm; const int tl = wave * 16 + lane, tg = blk * 128 + tl;
#pragma unroll
                    for (int k = 0; k < 4; ++k) { gatew[(size_t)tg * 4 + k] = ex[k] * inv; const int rk = atomicAdd((int*)&hist[ti[k]], 1); rec[tl * 4 + k] = (ti[k] << 16) | rk; }
                }
                __syncthreads();
                if (tid < 32) basee[tid] = (int)__hip_atomic_fetch_add(gcnt + tid * 16, (unsigned)hist[tid], RLX_AGENT);
                __syncthreads();
                { const int r = rec[tid], e = r >> 16, pos = basee[e] + (r & 0xffff), tg = blk * 128 + (tid >> 2), k = tid & 3;
                  list[(size_t)e * T + pos] = tg * 4 + k; toke[(size_t)tg * 4 + k] = e * T + pos; }
                __syncthreads();
            }
        }
        GRID_BAR();
        if (PH(9)) { PH_BEGIN
            if (tid < 32) Lcnt[tid] = (int)__hip_atomic_load(ctl + CW_CNT + (layer * 32 + tid) * 16, RLX_AGENT);
            __syncthreads();
            if (tid == 0) { int s = 0; for (int e = 0; e < 32; ++e) { Ltstart[e] = s; s += (Lcnt[e] + 255) >> 8; } Ltstart[32] = s; }
            __syncthreads();
            for (int e = 0; e < 32; ++e) { const int t0 = Ltstart[e], t1 = Ltstart[e + 1]; for (int i = t0 + tid; i < t1; i += 512) Ltilee[i] = e; }
            __syncthreads();
        }
        for (int rep_ = 0; rep_ < REPS(10); ++rep_) {
        if (PH(10)) { PH_BEGIN
            MoeSched<true> S{Lcnt, Ltstart, Ltilee, list, 8, 2048, G, bid};
            EpiSwiglu E{(unsigned char*)ACT, bgup + (size_t)layer * 32 * 2048};
            pg8::gemm_phase<EpiSwiglu, MoeSched<true>, true, true>(lds, Hb, (const bf16*)((const unsigned char*)Wgu + (size_t)layer * 32 * 2048 * 1024), S, E);
        }
        GRID_BAR(); }
        for (int rep_ = 0; rep_ < REPS(11); ++rep_) {
        if (PH(11)) { PH_BEGIN
            MoeSched<false> S{Lcnt, Ltstart, Ltilee, list, 4, 1024, G, bid};
            EpiDown E{(unsigned char*)Yb, pp->in[I_BDN] + (size_t)layer * 32 * 1024};
            pg8::gemm_phase<EpiDown, MoeSched<false>, true, true>(lds, ACT, (const bf16*)((const unsigned char*)Wdn + (size_t)layer * 32 * 1024 * 1024), S, E);
        }
        GRID_BAR(); }
        for (int rep_ = 0; rep_ < REPS(12); ++rep_) {
        if (PH(12)) { PH_BEGIN
            float* xo = pp->out;
            LAS float* g2v = (LAS float*)ldsp; LAS float* gsc1 = g2v + 1024; LAS float* sh1 = gsc1 + 1024;
            for (int blk = bid; blk < T / 128; blk += G) {
                const int b = blk >> 5; const float* md = mdL + (size_t)b * 6144; const float* md1 = modF + (size_t)(8 + b) * 6144;
                for (int i = tid; i < 1024; i += 512) { g2v[i] = md[5 * 1024 + i]; gsc1[i] = pp->in[I_MIXN][1024 + i] * (1.0f + md1[1024 + i]); sh1[i] = md1[i]; }
                __syncthreads();
                const int tok0 = blk * 128 + wave * 16;
                const int inf_l = toke[(size_t)tok0 * 4 + lane]; const float gk_l = gatew[(size_t)tok0 * 4 + lane];
                const int sl_l = Ltstart[inf_l >> 15] * 256 + (inf_l & (T - 1));
                f32x4 xa[4], xb[4]; unsigned ya[4][4], yb[4][4];
#define C_LOAD(q, X_, Y_) do { const int tok_ = tok0 + (q); \
                    _Pragma("unroll") for (int j = 0; j < 4; ++j) { const v2u xw_ = *(const v2u*)(X1 + (size_t)tok_ * 1024 + 4 * lane + 256 * j); X_[j] = (f32x4){bf_lo(xw_.x), bf_hi(xw_.x), bf_lo(xw_.y), bf_hi(xw_.y)}; } \
                    _Pragma("unroll") for (int k = 0; k < 4; ++k) { const int sk = __builtin_amdgcn_readlane(sl_l, 4 * (q) + k); \
                        _Pragma("unroll") for (int j = 0; j < 4; ++j) Y_[k][j] = __builtin_nontemporal_load((const unsigned*)((const unsigned char*)Yb + (size_t)sk * 1024 + 4 * lane + 256 * j)); } } while (0)
#define C_PROC(q, X_, Y_) do { const int tok_ = tok0 + (q); float gk[4]; \
                    _Pragma("unroll") for (int k = 0; k < 4; ++k) gk[k] = __int_as_float(__builtin_amdgcn_readlane(__float_as_int(gk_l), 4 * (q) + k)); \
                    f32x4 v[4]; float ss = 0.f; \
                    _Pragma("unroll") for (int j = 0; j < 4; ++j) { const int c = 4 * lane + 256 * j; f32x4 a = {0.f, 0.f, 0.f, 0.f}; \
                        _Pragma("unroll") for (int k = 0; k < 4; ++k) { const f32x2_c lo_ = __builtin_amdgcn_cvt_pk_f32_fp8((int)Y_[k][j], false), hi_ = __builtin_amdgcn_cvt_pk_f32_fp8((int)Y_[k][j], true); a[0] += gk[k] * lo_[0]; a[1] += gk[k] * lo_[1]; a[2] += gk[k] * hi_[0]; a[3] += gk[k] * hi_[1]; } \
                        v[j] = X_[j] + *(const LAS f32x4*)(g2v + c) * a; \
                        if (layer == 0) { v2u w_; w_.x = cvt_pk_bf16(v[j][0], v[j][1]); w_.y = cvt_pk_bf16(v[j][2], v[j][3]); *(v2u*)(X2 + (size_t)tok_ * 1024 + c) = w_; } else __builtin_nontemporal_store(v[j], (f32x4*)(xo + (size_t)tok_ * 1024 + c)); \
                        ss += (v[j][0] * v[j][0] + v[j][1] * v[j][1]) + (v[j][2] * v[j][2] + v[j][3] * v[j][3]); } \
                    if (layer == 0) { const float rs = rsqrtf(wave_sum(ss) * (1.0f / 1024.0f) + RMS_EPS); \
                        _Pragma("unroll") for (int j = 0; j < 4; ++j) { const int c = 4 * lane + 256 * j; const f32x4 o = v[j] * rs * *(const LAS f32x4*)(gsc1 + c) + *(const LAS f32x4*)(sh1 + c); \
                            v2u w; w.x = cvt_pk_bf16(o[0], o[1]); w.y = cvt_pk_bf16(o[2], o[3]); *(v2u*)(Hb + (size_t)tok_ * 1024 + c) = w; } } } while (0)
                C_LOAD(0, xa, ya);
                for (int q = 0; q < 16; q += 2) {
                    C_LOAD(q + 1, xb, yb);
                    C_PROC(q, xa, ya);
                    if (q + 2 < 16) C_LOAD(q + 2, xa, ya);
                    C_PROC(q + 1, xb, yb);
                }
#undef C_LOAD
#undef C_PROC
                __syncthreads();
            }
        }
        if (layer == 0 || rep_ + 1 < REPS(12)) GRID_BAR(); }
    }
#if defined(PROBE_GEMM)
    {
        GRID_BAR();
        PH_BEGIN
        const int layer = 1;
        MoeSched<false> S{Lcnt, Ltstart, Ltilee, list, 4, 1024, G, bid};
        EpiDown E{(unsigned char*)(ws + WS_Q), pp->in[I_BDN] + (size_t)layer * 32 * 1024};
        pg8::gemm_phase<EpiDown, MoeSched<false>, true, true, PROBE_GEMM>(lds, ACT, (const bf16*)((const unsigned char*)Wdn + (size_t)layer * 32 * 1024 * 1024), S, E);
    }
#endif
#if defined(PROBE_MFMA)
    {
        typedef int v8i_p __attribute__((ext_vector_type(8)));
        v8i_p a8, b8; bf16x8 a4, b4;
#pragma unroll
        for (int j = 0; j < 8; ++j) { a8[j] = 0x38383838 + (int)threadIdx.x; b8[j] = 0x3c3c3c3c - (int)threadIdx.x; a4[j] = (short)(0x3f80 + j); b4[j] = (short)(0x3f00 + j); }
        f32x4 pa[16];
#pragma unroll
        for (int j = 0; j < 16; ++j) pa[j] = (f32x4){0.f, 0.f, 0.f, 0.f};
#pragma nounroll
        for (int it = 0; it < 4000; ++it) {
#pragma unroll
            for (int j = 0; j < 16; ++j) {
#if PROBE_MFMA == 1
                pa[j] = __builtin_amdgcn_mfma_scale_f32_16x16x128_f8f6f4(a8, b8, pa[j], 0, 0, 0, 0x7f7f7f7f, 0, 0x7f7f7f7f);
#else
                pa[j] = __builtin_amdgcn_mfma_f32_16x16x32_bf16(a4, b4, pa[j], 0, 0, 0);
#endif
            }
            asm volatile("" : "+v"(a8), "+v"(b8), "+v"(a4), "+v"(b4));
        }
#pragma unroll
        for (int j = 0; j < 16; ++j) asm volatile("" :: "v"(pa[j]));
    }
#endif
}

extern "C" void kernel_launch(void* const* d_in, const int* in_sizes, int n_in, void* d_out, int out_size, void* d_ws, size_t ws_size, hipStream_t stream) {
    static int grid = 0;
    if (grid == 0) {
        if (n_in != 27 || out_size != T * DM || ws_size < WS_END) { fprintf(stderr, "kernel_launch: unexpected shapes (n_in %d out %d ws %zu)\n", n_in, out_size, ws_size); grid = -1; return; }
        int dev = 0, cus = 0, per_cu = 0;
        if (hipGetDevice(&dev) != hipSuccess || hipDeviceGetAttribute(&cus, hipDeviceAttributeMultiprocessorCount, dev) != hipSuccess) { grid = -1; return; }
        if (hipFuncSetAttribute((const void*)fwd, hipFuncAttributeMaxDynamicSharedMemorySize, LDS_BYTES) != hipSuccess) { fprintf(stderr, "kernel_launch: hipFuncSetAttribute failed\n"); grid = -1; return; }
        if (hipOccupancyMaxActiveBlocksPerMultiprocessor(&per_cu, (const void*)fwd, 512, LDS_BYTES) != hipSuccess || per_cu < 1) fprintf(stderr, "kernel_launch: occupancy query reports %d\n", per_cu);
        (void)hipGetLastError();
        grid = cus;
    }
    if (grid < 0) return;
    if (hipMemsetAsync((char*)d_ws + WS_CTL, 0, CTL_ZERO_BYTES, stream) != hipSuccess) return;
    Params p{};
    for (int i = 0; i < 27; ++i) p.in[i] = (const float*)d_in[i];
    p.out = (float*)d_out; p.ws = (unsigned char*)d_ws;
    for (int i = 0; i < 32; ++i) p.invf[i] = (float)std::pow(10000.0, -(double)(2 * i) / 64.0);
    hipLaunchKernelGGL(fwd, dim3(grid), dim3(512), LDS_BYTES, stream, p);
}
```

```cpp
#include <hip/hip_runtime.h>
#include <hip/hip_bf16.h>
#include <cstdio>
#include <cstdint>
#include <cmath>

constexpr int NB = 8, SEQ = 4096, T = NB * SEQ, DM = 1024;
constexpr int NEXP = 32, TOPK = 4, NASG = T * TOPK;
constexpr int MAXMT = NASG / 256 + NEXP;
constexpr int MLN = 3328;
constexpr float RMS_EPS = 1e-6f;
constexpr float C2Q = 0.125f * 1.4426950408889634f;
constexpr float WSCALE = 32.0f, WSCALE_INV = 1.0f / 32.0f;

#define GAS __attribute__((address_space(1)))
#define LAS __attribute__((address_space(3)))
typedef unsigned short bf16;
typedef unsigned v4u __attribute__((ext_vector_type(4)));
typedef unsigned v2u __attribute__((ext_vector_type(2)));
typedef float f32x4 __attribute__((ext_vector_type(4)));
typedef float f32x16 __attribute__((ext_vector_type(16)));
typedef short bf16x8 __attribute__((ext_vector_type(8)));
#define RLX_AGENT __ATOMIC_RELAXED, __HIP_MEMORY_SCOPE_AGENT
#define LDS_WAIT() asm volatile("s_waitcnt lgkmcnt(0)" ::: "memory")
#define VM_WAIT() asm volatile("s_waitcnt vmcnt(0)" ::: "memory")

typedef float f32x2_c __attribute__((ext_vector_type(2))); typedef __bf16 bf16x2_c __attribute__((ext_vector_type(2)));
__device__ __forceinline__ unsigned cvt_pk_bf16(float lo, float hi) { const f32x2_c v = {lo, hi}; const bf16x2_c b = __builtin_convertvector(v, bf16x2_c); return __builtin_bit_cast(unsigned, b); }
__device__ __forceinline__ v2u pack8_fp8(const float (&x)[8]) {
    float c[8];
#pragma unroll
    for (int j = 0; j < 8; ++j) c[j] = x[j];
    int w0 = 0, w1 = 0;
    w0 = __builtin_amdgcn_cvt_pk_fp8_f32(c[0], c[1], w0, false); w0 = __builtin_amdgcn_cvt_pk_fp8_f32(c[2], c[3], w0, true);
    w1 = __builtin_amdgcn_cvt_pk_fp8_f32(c[4], c[5], w1, false); w1 = __builtin_amdgcn_cvt_pk_fp8_f32(c[6], c[7], w1, true);
    v2u r; r.x = (unsigned)w0; r.y = (unsigned)w1; return r;
}
__device__ __forceinline__ float bf_lo(unsigned w) { return __uint_as_float(w << 16); }
__device__ __forceinline__ float bf_hi(unsigned w) { return __uint_as_float(w & 0xffff0000u); }
template <int CTRL, int ROW_MASK> __device__ __forceinline__ float dppf(float v) { return __int_as_float(__builtin_amdgcn_update_dpp(0, __float_as_int(v), CTRL, ROW_MASK, 0xf, true)); }
__device__ __forceinline__ float sum_lanes8(float v) { v += dppf<0xB1, 0xf>(v); v += dppf<0x4E, 0xf>(v); v += dppf<0x141, 0xf>(v); return v; }
__device__ __forceinline__ float sum_lanes16(float v) { v = sum_lanes8(v); v += dppf<0x140, 0xf>(v); return v; }
__device__ __forceinline__ float wave_sum(float v) {
    v = sum_lanes16(v);
    { const unsigned u = __float_as_uint(v); auto r = __builtin_amdgcn_permlane16_swap(u, u, false, false); v = __uint_as_float(r[0]) + __uint_as_float(r[1]); }
    { const unsigned u = __float_as_uint(v); auto r = __builtin_amdgcn_permlane32_swap(u, u, false, false); v = __uint_as_float(r[0]) + __uint_as_float(r[1]); }
    return v;
}
__device__ __forceinline__ float sum_fq4(float v) {
    { const unsigned u = __float_as_uint(v); auto r = __builtin_amdgcn_permlane16_swap(u, u, false, false); v = __uint_as_float(r[0]) + __uint_as_float(r[1]); }
    { const unsigned u = __float_as_uint(v); auto r = __builtin_amdgcn_permlane32_swap(u, u, false, false); v = __uint_as_float(r[0]) + __uint_as_float(r[1]); }
    return v;
}
__device__ __forceinline__ float sigmoidf_(float z) { return __builtin_amdgcn_rcpf(1.0f + __builtin_amdgcn_exp2f(-1.4426950408889634f * z)); }

namespace pg8 {
#define PG8_LAS __attribute__((address_space(3)))
typedef unsigned short bf16_t;
typedef short bf16x8 __attribute__((ext_vector_type(8)));
typedef float f32x4 __attribute__((ext_vector_type(4)));
typedef unsigned u32x4 __attribute__((ext_vector_type(4)));
typedef int v4i_t __attribute__((ext_vector_type(4)));
constexpr int BM = 256, BK = 64, HALF = 128, HTB = HALF * BK * 2, STAGE_BYTES = 8 * HTB, NXCD = 8, WGM = 8;
constexpr int KD = 1024;

__host__ __device__ __forceinline__ int lds_byte(int r, int c) { const int st = (r >> 4) * 2 + (c >> 5), rr = r & 15, cc = c & 31, ob = rr * 64 + cc * 2; return st * 1024 + (ob ^ (((ob >> 9) & 1) << 5)); }
__host__ __device__ __forceinline__ void stage_rc(int b, int& R, int& C) { const int st = b / 1024, sb = b % 1024, swz = sb ^ (((sb >> 9) & 1) << 5); R = (st >> 1) * 16 + swz / 64; C = (st & 1) * 32 + (swz % 64) / 2; }
__host__ __device__ __forceinline__ int perm32(int rho) { const int n = rho >> 4, i = rho & 15; return 8 * (i >> 2) + 4 * n + (i & 3); }

struct Unit { int pm, pn, e; };
struct EpiPre { f32x4 v[4]; };

struct DenseSched {
    static constexpr bool GATHER = false;
    int nM, nN, nwg, G, c;
    __device__ void init(int M, int N, int G_, int c_) { nM = M / BM; nN = N / BM; nwg = nM * nN; G = G_; c = c_; }
    __device__ __forceinline__ bool next(int i, Unit& u) const {
        const long L = (long)i * G + c; if (L >= nwg) return false;
        int wgid = (int)L; { const int q = nwg / NXCD, r = nwg % NXCD, xcd = wgid % NXCD, off = wgid / NXCD; wgid = (xcd < r ? xcd * (q + 1) : r * (q + 1) + (xcd - r) * q) + off; }
        const int nig = WGM * nN, gid = wgid / nig, fm = gid * WGM, gsz = (nM - fm) < WGM ? (nM - fm) : WGM;
        u.pm = fm + ((wgid % nig) % gsz); u.pn = (wgid % nig) / gsz; u.e = 0; return true;
    }
    __device__ __forceinline__ unsigned a_row(const Unit& u, int r) const { return (unsigned)(u.pm * BM + r); }
    __device__ __forceinline__ unsigned b_row0(const Unit& u) const { return (unsigned)(u.pn * BM); }
};

template <class Epi, class Sched, bool ALIGN_EPI, bool F8 = false, int PROBE = 0>
__device__ __forceinline__ void gemm_phase(PG8_LAS unsigned char* lds, const bf16_t* A, const bf16_t* Bt, const Sched& S, const Epi& E) {
    int tid_ = threadIdx.x; asm volatile("" : "+v"(tid_));
    const int tid = tid_, wid = __builtin_amdgcn_readfirstlane(tid >> 6), lane = tid & 63, wr = wid >> 2, wc = wid & 3, fr = lane & 15, fq = lane >> 4;
    constexpr int K = F8 ? KD / 2 : KD, nt = K / BK;
    int Rr[2], Cc[2];
#pragma unroll
    for (int i = 0; i < 2; ++i) { int R, C; stage_rc(tid * 16 + i * 8192, R, C); Rr[i] = R; Cc[i] = C; }
    const unsigned cpart = (unsigned)(((lane & 3) * 8) ^ ((lane >> 5) * 16));
    const unsigned laneA = ((unsigned)(lane >> 2) * (unsigned)K + cpart) * 2u, laneB = ((unsigned)(8 * (lane >> 4) + ((lane >> 2) & 3)) * (unsigned)K + cpart) * 2u;
    constexpr size_t kstep = (size_t)(BK * 2);
    const unsigned ldsw = (unsigned)wid * 1024u;
    const int aoff = lds_byte(wr * 64 + fr, fq * 8), boff = lds_byte(wc * 32 + fr, fq * 8);
#define PG8_SA(b, h) (((b) * 2 + (h)) * HTB)
#define PG8_SB(b, h) ((4 + (b) * 2 + (h)) * HTB)
#define PG8_SOFF_A(_i, hh) ((size_t)(((((wid + 8 * (_i)) >> 1) * 16 + (hh) * HALF) * K + ((wid + 8 * (_i)) & 1) * 32) * 2))
#define PG8_SOFF_B(_i, hh) ((size_t)(((((wid + 8 * (_i)) >> 2) * 32 + 4 * (((wid + 8 * (_i)) >> 1) & 1) + (hh) * HALF) * K + ((wid + 8 * (_i)) & 1) * 32) * 2))
#define PG8_DMA(bufoff, _i, sptr, lanev) do { if constexpr ((PROBE & 2) != 0) break; const char* sp_ = (sptr); asm volatile("" : "+s"(sp_)); unsigned vo_ = (lanev); asm volatile("" : "+v"(vo_)); \
        __builtin_amdgcn_global_load_lds((const unsigned*)(sp_ + (size_t)vo_), (PG8_LAS unsigned*)(lds + (bufoff) + ldsw + (_i) * 8192), 16, 0, 0); } while (0)
#define PG8_STAGE_B(bufoff, hh, sbyte) do { _Pragma("unroll") for (int _i = 0; _i < 2; ++_i) PG8_DMA(bufoff, _i, Bb + (size_t)(sbyte) + PG8_SOFF_B(_i, hh), laneB); } while (0)
#define PG8_STAGE_AC(bufoff, hh, sbyte) do { _Pragma("unroll") for (int _i = 0; _i < 2; ++_i) PG8_DMA(bufoff, _i, Ab + (size_t)(sbyte) + PG8_SOFF_A(_i, hh), laneA); } while (0)
#define PG8_STAGE_AX(bufoff, offs, kbyte) do { _Pragma("unroll") for (int _i = 0; _i < 2; ++_i) PG8_DMA(bufoff, _i, Ab + (size_t)(kbyte), (offs)[_i]); } while (0)
#define PG8_STA_CUR(bufoff, hh, kb) do { if constexpr (GATHER) { PG8_STAGE_AX(bufoff, aoc[hh], kb); } else { PG8_STAGE_AC(bufoff, hh, cA + (size_t)(kb)); } } while (0)
#define PG8_STA_NXT(bufoff, hh, ex) do { if constexpr (GATHER) { PG8_STAGE_AX(bufoff, o2[hh], kb2 + (size_t)(ex)); } else { PG8_STAGE_AC(bufoff, hh, a2s + (size_t)(ex)); } } while (0)
#define PG8_LDA(dst, b, h) do { _Pragma("unroll") for (int m = 0; m < 4; ++m) _Pragma("unroll") for (int k = 0; k < 2; ++k) dst[m][k] = *(const PG8_LAS bf16x8*)(lds + PG8_SA(b, h) + aoff + m * 2048 + k * 1024); } while (0)
#define PG8_LDB(dst, b, h) do { _Pragma("unroll") for (int n = 0; n < 2; ++n) _Pragma("unroll") for (int k = 0; k < 2; ++k) dst[n][k] = *(const PG8_LAS bf16x8*)(lds + PG8_SB(b, h) + boff + n * 2048 + k * 1024); } while (0)
#define PG8_MMA(ai, bj, At, Bt_) do { if constexpr ((PROBE & 1) != 0) break; __builtin_amdgcn_s_setprio(1); _Pragma("unroll") for (int m = 0; m < 4; ++m) _Pragma("unroll") for (int n = 0; n < 2; ++n) { \
        if constexpr (F8) { const v4i_t b0_ = __builtin_bit_cast(v4i_t, Bt_[n][0]), b1_ = __builtin_bit_cast(v4i_t, Bt_[n][1]), a0_ = __builtin_bit_cast(v4i_t, At[m][0]), a1_ = __builtin_bit_cast(v4i_t, At[m][1]); \
            acc[ai][bj][m][n] = __builtin_amdgcn_mfma_scale_f32_16x16x128_f8f6f4(__builtin_shufflevector(b0_, b1_, 0, 1, 2, 3, 4, 5, 6, 7), __builtin_shufflevector(a0_, a1_, 0, 1, 2, 3, 4, 5, 6, 7), acc[ai][bj][m][n], 0, 0, 0, 0x7f7f7f7f, 0, 0x7f7f7f7f); } \
        else { _Pragma("unroll") for (int k = 0; k < 2; ++k) acc[ai][bj][m][n] = __builtin_amdgcn_mfma_f32_16x16x32_bf16(Bt_[n][k], At[m][k], acc[ai][bj][m][n], 0, 0, 0); } } \
        __builtin_amdgcn_s_setprio(0); } while (0)
#define PG8_WAIT_V(n) asm volatile("s_waitcnt vmcnt(" #n ")" ::: "memory")
#define PG8_WAIT_L(n) asm volatile("s_waitcnt lgkmcnt(" #n ")" ::: "memory")
#define PG8_BAR __builtin_amdgcn_s_barrier()
#define PG8_SCHED __builtin_amdgcn_sched_barrier(0)
    Unit cur, nxt; int ui = 0;
    if (!S.next(0, cur)) return;
    EpiPre pre; E.prefetch(pre, cur, wr, wc, fr, fq);
    f32x4 acc[2][2][4][2];
#pragma unroll
    for (int a = 0; a < 2; ++a)
#pragma unroll
        for (int b = 0; b < 2; ++b)
#pragma unroll
            for (int m = 0; m < 4; ++m)
#pragma unroll
                for (int n = 0; n < 2; ++n) acc[a][b][m][n] = (f32x4){0.f, 0.f, 0.f, 0.f};
    bf16x8 At[4][2], B0[2][2], B1[2][2];
    const char* Ab = (const char*)A;
    constexpr bool GATHER = Sched::GATHER;
    unsigned aoc[2][2], aon[2][2]; size_t cA = 0, nA = 0;
#pragma unroll
    for (int h = 0; h < 2; ++h)
#pragma unroll
        for (int i = 0; i < 2; ++i) { aoc[h][i] = 0u; aon[h][i] = 0u;
            if constexpr (GATHER) aoc[h][i] = (S.a_row(cur, h * HALF + Rr[i]) * (unsigned)K + (unsigned)Cc[i]) * 2u; }
    if constexpr (!GATHER) cA = (size_t)S.a_row(cur, 0) * (size_t)(K * 2);
    const char* Bb = (const char*)Bt; size_t cB = (size_t)S.b_row0(cur) * (size_t)(K * 2);
    PG8_STAGE_B(PG8_SB(0, 0), 0, cB); PG8_STAGE_B(PG8_SB(0, 1), 1, cB); PG8_STA_CUR(PG8_SA(0, 0), 0, 0); PG8_STA_CUR(PG8_SA(0, 1), 1, 0);
    if (wr == 1) PG8_BAR;
    PG8_WAIT_V(2); PG8_BAR;
    PG8_STAGE_B(PG8_SB(1, 0), 0, cB + kstep); PG8_STA_CUR(PG8_SA(1, 0), 0, kstep); PG8_STAGE_B(PG8_SB(1, 1), 1, cB + kstep);
    PG8_WAIT_V(6); PG8_BAR;
    for (;;) {
        const bool has_next = S.next(ui + 1, nxt);
        size_t nB = cB;
        nA = cA;
        if (has_next) {
            if constexpr (GATHER) {
#pragma unroll
                for (int h = 0; h < 2; ++h)
#pragma unroll
                    for (int i = 0; i < 2; ++i) aon[h][i] = (S.a_row(nxt, h * HALF + Rr[i]) * (unsigned)K + (unsigned)Cc[i]) * 2u;
            } else nA = (size_t)S.a_row(nxt, 0) * (size_t)(K * 2);
            nB = (size_t)S.b_row0(nxt) * (size_t)(K * 2);
        } else {
#pragma unroll
            for (int h = 0; h < 2; ++h)
#pragma unroll
                for (int i = 0; i < 2; ++i) aon[h][i] = aoc[h][i];
        }
#pragma nounroll
        for (int t = 0; t < nt; t += 2) {
            const bool last = (t == nt - 2);
            const size_t kb1 = (size_t)(t + 1) * kstep;
            const size_t kb2 = last ? (size_t)0 : (size_t)(t + 2) * kstep;
            unsigned o2[2][2];
#pragma unroll
            for (int h = 0; h < 2; ++h)
#pragma unroll
                for (int i = 0; i < 2; ++i) o2[h][i] = last ? aon[h][i] : aoc[h][i];
            const size_t a2s = last ? nA : cA + (size_t)(t + 2) * kstep; (void)a2s;
            const size_t b2 = last ? nB : cB + (size_t)(t + 2) * kstep;
            const size_t b3 = b2 + kstep;
            PG8_LDB(B0, 0, 0); PG8_LDB(B1, 0, 1); PG8_SCHED; PG8_LDA(At, 0, 0); PG8_STA_CUR(PG8_SA(1, 1), 1, kb1);
            PG8_WAIT_V(8); PG8_WAIT_L(0); PG8_BAR; PG8_MMA(0, 0, At, B0); PG8_MMA(0, 1, At, B1); PG8_BAR; PG8_SCHED;
            PG8_LDA(At, 0, 1); PG8_STAGE_B(PG8_SB(0, 0), 0, b2); PG8_STAGE_B(PG8_SB(0, 1), 1, b2); PG8_STA_NXT(PG8_SA(0, 0), 0, 0);
            PG8_WAIT_V(8); PG8_WAIT_L(0); PG8_BAR; PG8_MMA(1, 0, At, B0); PG8_MMA(1, 1, At, B1); PG8_BAR; PG8_SCHED;
            PG8_LDB(B0, 1, 0); PG8_LDB(B1, 1, 1); PG8_SCHED; PG8_LDA(At, 1, 0); PG8_STA_NXT(PG8_SA(0, 1), 1, 0);
            PG8_WAIT_V(8); PG8_WAIT_L(0); PG8_BAR; PG8_MMA(0, 0, At, B0); PG8_MMA(0, 1, At, B1); PG8_BAR; PG8_SCHED;
            PG8_LDA(At, 1, 1); PG8_STAGE_B(PG8_SB(1, 0), 0, b3); PG8_STAGE_B(PG8_SB(1, 1), 1, b3); PG8_STA_NXT(PG8_SA(1, 0), 0, kstep);
            PG8_WAIT_V(8); PG8_WAIT_L(0); PG8_BAR; PG8_MMA(1, 0, At, B0); PG8_MMA(1, 1, At, B1); PG8_BAR; PG8_SCHED;
        }
        if constexpr (ALIGN_EPI) { if (wr == 0) PG8_BAR; }
        E(acc, cur, wr, wc, fr, fq, pre);
        if (!has_next) break;
#pragma unroll
        for (int a = 0; a < 2; ++a)
#pragma unroll
            for (int b = 0; b < 2; ++b)
#pragma unroll
                for (int m = 0; m < 4; ++m)
#pragma unroll
                    for (int n = 0; n < 2; ++n) acc[a][b][m][n] = (f32x4){0.f, 0.f, 0.f, 0.f};
        cur = nxt; cB = nB; cA = nA; ++ui;
        E.prefetch(pre, cur, wr, wc, fr, fq);
#pragma unroll
        for (int h = 0; h < 2; ++h)
#pragma unroll
            for (int i = 0; i < 2; ++i) aoc[h][i] = aon[h][i];
        if constexpr (ALIGN_EPI) { if (wr == 1) PG8_BAR; }
    }
    PG8_WAIT_V(0);
    if constexpr (!ALIGN_EPI) { if (wr == 0) PG8_BAR; }
    PG8_BAR;
#undef PG8_SA
#undef PG8_SB
#undef PG8_STAGE_AX
#undef PG8_STA_CUR
#undef PG8_STA_NXT
#undef PG8_STAGE_B
#undef PG8_STAGE_AC
#undef PG8_DMA
#undef PG8_SOFF_A
#undef PG8_SOFF_B
#undef PG8_LDA
#undef PG8_LDB
#undef PG8_MMA
#undef PG8_WAIT_V
#undef PG8_WAIT_L
#undef PG8_BAR
#undef PG8_SCHED
}
}

namespace attn_body {
using bf16h=__hip_bfloat16;
using bf16x8=__attribute__((ext_vector_type(8)))short;
using s16x4=__attribute__((ext_vector_type(4)))short;
using f32x16=__attribute__((ext_vector_type(16)))float;
using u32x4=__attribute__((ext_vector_type(4)))unsigned;
constexpr int D=64,PITCH=1024,OPITCH=2048;
constexpr int NW=8,QBLK=32,QB=QBLK*NW,KVBLK=64;
__device__ __forceinline__ int crow(int r,int hi){return (r&3)+8*(r>>2)+4*hi;}
#define SBAR() __builtin_amdgcn_sched_barrier(0)
__device__ __forceinline__ void cmask(f32x16&p0,f32x16&p1,int jb,int qrel,int hi){
  const float NEG=-INFINITY; int kb=64*jb+4*hi;
  #pragma unroll
  for(int r=0;r<16;++r){int kv=kb+(r&3)+8*(r>>2); if(kv>qrel)p0[r]=NEG; if(kv+32>qrel)p1[r]=NEG;}
}
constexpr int NSLOT=3, SLOTB=8192;
constexpr int LDS_K=0, LDS_V=NSLOT*SLOTB, LDS_WS=2*NSLOT*SLOTB, LDS_OST=LDS_WS+NW*64*4, LDS_BYTES=LDS_OST+NW*4096;
__device__ __forceinline__ void glds16(const void*gsrc,unsigned lds_dst){unsigned keep;
  asm volatile("s_mov_b32 %0, m0\n\ts_mov_b32 m0, %2\n\ts_nop 0\n\tglobal_load_lds_dwordx4 %1, off\n\ts_mov_b32 m0, %0":"=&s"(keep):"v"(gsrc),"s"(lds_dst):"memory");}
__device__ __forceinline__ float max3f(float a,float b,float c){float r;asm("v_max3_f32 %0, %1, %2, %3":"=v"(r):"v"(a),"v"(b),"v"(c));return r;}
__device__ __forceinline__ float max2f(float a,float b){float r;asm("v_max_f32_e32 %0, %1, %2":"=v"(r):"v"(a),"v"(b));return r;}
__device__ __forceinline__ float fadd_s(float a,float b){float r;asm("v_add_f32_e32 %0, %1, %2":"=v"(r):"v"(a),"v"(b));return r;}
__device__ __forceinline__ float fsub_s(float a,float b){float r;asm("v_sub_f32_e32 %0, %1, %2":"=v"(r):"v"(a),"v"(b));return r;}
typedef float f32x2_t __attribute__((ext_vector_type(2))); typedef __bf16 bf16x2_t __attribute__((ext_vector_type(2)));
__device__ __forceinline__ unsigned cvtpk_s(float lo,float hi){f32x2_t v={lo,hi};bf16x2_t b=__builtin_convertvector(v,bf16x2_t);return __builtin_bit_cast(unsigned,b);}
#define WAIT_BAR(N) asm volatile("s_waitcnt vmcnt(" #N ") lgkmcnt(0)\n\ts_barrier":::"memory")
__device__ __forceinline__ void qkt(f32x16&p0,f32x16&p1,const char*Kslot,const bf16x8*qr,const f32x16&negm,int r32,int hi){
  const char*kb=Kslot+hi*1024+r32*16;
  #pragma unroll
  for(int d0=0;d0<4;++d0){
    const bf16x8 b0=*reinterpret_cast<const bf16x8*>(kb+d0*2048);
    const bf16x8 b1=*reinterpret_cast<const bf16x8*>(kb+d0*2048+512);
    if(d0==0){p0=__builtin_amdgcn_mfma_f32_32x32x16_bf16(b0,qr[0],negm,0,0,0);p1=__builtin_amdgcn_mfma_f32_32x32x16_bf16(b1,qr[0],negm,0,0,0);}
    else{p0=__builtin_amdgcn_mfma_f32_32x32x16_bf16(b0,qr[d0],p0,0,0,0);p1=__builtin_amdgcn_mfma_f32_32x32x16_bf16(b1,qr[d0],p1,0,0,0);}}
}
typedef __attribute__((address_space(3))) const char* lds_cptr;
typedef short v4i16_t __attribute__((ext_vector_type(4)));
__device__ __forceinline__ void kload8(bf16x8*kf,lds_cptr kp){
  kf[0]=*(const __attribute__((address_space(3))) bf16x8*)(kp);      kf[1]=*(const __attribute__((address_space(3))) bf16x8*)(kp+512);
  kf[2]=*(const __attribute__((address_space(3))) bf16x8*)(kp+2048); kf[3]=*(const __attribute__((address_space(3))) bf16x8*)(kp+2560);
  kf[4]=*(const __attribute__((address_space(3))) bf16x8*)(kp+4096); kf[5]=*(const __attribute__((address_space(3))) bf16x8*)(kp+4608);
  kf[6]=*(const __attribute__((address_space(3))) bf16x8*)(kp+6144); kf[7]=*(const __attribute__((address_space(3))) bf16x8*)(kp+6656);
}
__device__ __forceinline__ void kload2(bf16x8*kf,lds_cptr kp,int j){ kf[2*j]=*(const __attribute__((address_space(3))) bf16x8*)(kp+j*2048); kf[2*j+1]=*(const __attribute__((address_space(3))) bf16x8*)(kp+j*2048+512); }
__device__ __forceinline__ s16x4 vtr(lds_cptr p){ return __builtin_bit_cast(s16x4,__builtin_amdgcn_ds_read_tr16_b64_v4i16((__attribute__((address_space(3))) v4i16_t*)p)); }
__device__ __forceinline__ float rowmax(const f32x16&p0,const f32x16&p1){
  float a=max3f(p0[0],p0[1],p1[0]),b=max3f(p0[2],p0[3],p1[1]);a=max3f(a,p1[2],p1[3]);
  #pragma unroll
  for(int r=4;r<16;r+=4){a=max3f(a,p0[r],p0[r+1]);b=max3f(b,p0[r+2],p0[r+3]);a=max3f(a,p1[r],p1[r+1]);b=max3f(b,p1[r+2],p1[r+3]);}
  const float m=max2f(a,b);
  auto rr=__builtin_amdgcn_permlane32_swap(__float_as_uint(m),__float_as_uint(m),false,false);
  return max2f(__uint_as_float(rr[0]),__uint_as_float(rr[1]));
}
__device__ __forceinline__ void pv(f32x16*o,int vb,bf16x8 pa0,bf16x8 pa1,bf16x8 pa2,bf16x8 pa3){
  #pragma unroll
  for(int d0=0;d0<2;++d0){s16x4 lo[4],hi[4];
    #pragma unroll
    for(int ks=0;ks<4;++ks){
      asm volatile("ds_read_b64_tr_b16 %0,%1 offset:%c2":"=&v"(lo[ks]):"v"(vb),"i"(d0*4096+ks*1024):"memory");
      asm volatile("ds_read_b64_tr_b16 %0,%1 offset:%c2":"=&v"(hi[ks]):"v"(vb),"i"(d0*4096+ks*1024+512):"memory");}
    asm volatile("s_waitcnt lgkmcnt(0)":::"memory");SBAR();
    #define PK(k) (bf16x8){lo[k][0],lo[k][1],lo[k][2],lo[k][3],hi[k][0],hi[k][1],hi[k][2],hi[k][3]}
    o[d0]=__builtin_amdgcn_mfma_f32_32x32x16_bf16(pa0,PK(0),o[d0],0,0,0);
    o[d0]=__builtin_amdgcn_mfma_f32_32x32x16_bf16(pa1,PK(1),o[d0],0,0,0);
    o[d0]=__builtin_amdgcn_mfma_f32_32x32x16_bf16(pa2,PK(2),o[d0],0,0,0);
    o[d0]=__builtin_amdgcn_mfma_f32_32x32x16_bf16(pa3,PK(3),o[d0],0,0,0);
    #undef PK
  }
}
#define ATTN_STORE16(p,v) (*(u32x4*)(p)=(v))
template<int THRL> __device__ __forceinline__ void attn_unit(int combo,int q0,const bf16h*Q,const bf16h*__restrict__ K,const bf16h*__restrict__ V,bf16h*O,char*shm){
  int tid_=threadIdx.x; asm volatile("":"+v"(tid_));
  const int tid=tid_,lane=tid&63,r32=lane&31,hi=lane>>5; const int wid=__builtin_amdgcn_readfirstlane(tid>>6);
  const int vh_=combo&1,cp_=(combo>>1)&1,hh_=(combo>>2)&7; const long rowbase=(long)(combo>>5)*4096;
  const bf16h*Qw=Q+(rowbase+q0+wid*QBLK)*PITCH+(2*hh_+cp_)*D;
  const bf16h*Kh=K+rowbase*PITCH+(2*hh_+cp_)*D,*Vh=V+rowbase*PITCH+(2*hh_+vh_)*D;
  const unsigned lds0=(unsigned)(uintptr_t)shm;
  float*wsf=(float*)(shm+LDS_WS)+wid*64;
  const bf16h*ksrc=Kh+(long)lane*PITCH+wid*8;
  const bf16h*vsrc=Vh+(long)(16*(wid&3)+(lane>>2))*PITCH+(wid>>2)*32+(lane&3)*8;
  const unsigned kdst=lds0+LDS_K+wid*1024, vdst=lds0+LDS_V+wid*1024;
  #define DMA_K(t,slot) glds16(ksrc+(long)(t)*KVBLK*PITCH,(unsigned)__builtin_amdgcn_readfirstlane(kdst+(slot)))
  #define DMA_V(t,slot) glds16(vsrc+(long)(t)*KVBLK*PITCH,(unsigned)__builtin_amdgcn_readfirstlane(vdst+(slot)))
  const char*Kbase=shm+LDS_K; bf16x8 kf[8];
  const lds_cptr shm3=(lds_cptr)shm; const lds_cptr kp0=shm3+LDS_K+hi*1024+r32*16; const lds_cptr vp0=shm3+LDS_V+((lane>>4)&1)*32+(lane&3)*8+(4*hi+((lane&15)>>2))*64;
  const int NT=(q0+QB)/KVBLK;
  DMA_K(0,0);DMA_V(0,0);DMA_K(1,SLOTB);
  bf16x8 qr[4];
  #pragma unroll
  for(int d0=0;d0<4;++d0)qr[d0]=*reinterpret_cast<const bf16x8*>(&Qw[(long)r32*PITCH+d0*16+hi*8]);
  float mhat=0.f,l_reg=0.f;f32x16 o[2];o[0]=f32x16{};o[1]=f32x16{};
  const int qrel=wid*QBLK+r32;
  #define CMASK(P0,P1,t) do{int jb_=(t)-(NT-4); if(jb_>=0)cmask(P0,P1,jb_,qrel,hi);}while(0)
  bool resc=false;
  #define START(P0,P1) do{ const float rm=rowmax(P0,P1); resc=false; \
    { const float dl=rm; mhat=fadd_s(mhat,dl); \
      _Pragma("unroll") for(int r=0;r<16;++r){P0[r]=fsub_s(P0[r],dl);P1[r]=fsub_s(P1[r],dl);} \
      } \
    _Pragma("unroll") for(int r=0;r<16;++r)P0[r]=__builtin_amdgcn_exp2f(P0[r]); }while(0)
  #define RESC() do{ if(resc){ asm volatile("s_waitcnt lgkmcnt(0)":::"memory"); \
      _Pragma("unroll") for(int d_=0;d_<2;++d_) _Pragma("unroll") for(int r=0;r<16;++r)o[d_][r]*=wsf[crow(r,hi)]; } }while(0)
  f32x16 pA0,pA1,pB0,pB1;
  int sl_prev=0,sl_cur=0,sl_next=SLOTB;
  #define ROT() do{sl_prev=sl_cur;sl_cur=sl_next;sl_next=(sl_next==(NSLOT-1)*SLOTB)?0:sl_next+SLOTB;}while(0)
  DMA_K(2,2*SLOTB);
  WAIT_BAR(3);
  qkt(pA0,pA1,Kbase,qr,f32x16{},r32,hi);asm volatile("s_nop 15\n\ts_nop 7":"+v"(pA0),"+v"(pA1));CMASK(pA0,pA1,0);
  START(pA0,pA1);
  _Pragma("unroll") for(int r=0;r<16;++r)pA1[r]=__builtin_amdgcn_exp2f(pA1[r]);
  WAIT_BAR(0);
  DMA_K(3,0);DMA_V(1,SLOTB);
  ROT();
  kload8(kf,kp0+sl_cur);
  WAIT_BAR(2);
  s16x4 vlo[8],vhi[8]; u32x4 pw0,pw1,pw2,pw3;
  #define PKW(P,B) cvtpk_s(P[B],P[B+1])
  #define PAF(k) __builtin_bit_cast(bf16x8,pw##k)
  #define VFR(i) (bf16x8){vlo[i][0],vlo[i][1],vlo[i][2],vlo[i][3],vhi[i][0],vhi[i][1],vhi[i][2],vhi[i][3]}
  #define PIN(x) asm volatile("":"+v"(x))
  #define MX3(a,b,c) __builtin_fmaxf(__builtin_fmaxf((a),(b)),(c))
  #define GAPA(MF,A0,A1,A2,A3,W0,W1,PW) do{ MF; sacc+=A0; sacc+=A1; sacc+=A2; sacc+=A3; PIN(sacc); W0; W1; PIN(PW); SBAR(); }while(0)
  #define EX(v) __builtin_amdgcn_exp2f(v)
  #define GAPB(MF,X,B) do{ MF; X[B]=EX(X[B]); X[B+1]=EX(X[B+1]); X[B+2]=EX(X[B+2]); X[B+3]=EX(X[B+3]); PIN(X); SBAR(); }while(0)
  #define VRD(i) do{ vlo[i]=vtr(vp_+(((i)>>2)*4096+((i)&3)*1024)); vhi[i]=vtr(vp_+(((i)>>2)*4096+((i)&3)*1024+512)); }while(0)
  #define KRD(G,j) do{ if(G){ kload2(kf,kp0+sl_next,j); SBAR(); } }while(0)
  #define STEP(C0,C1,P0,P1,t,GK,GV,GL) do{ SBAR(); \
    const lds_cptr vp_=vp0+sl_prev; \
    VRD(0); SBAR(); float sacc=(P0[0]+P0[1]); \
    GAPA(C0=__builtin_amdgcn_mfma_f32_32x32x16_bf16(kf[0],qr[0],f32x16{},0,0,0), P0[2],P0[3],P0[4],P0[5],     pw0[0]=PKW(P0,0), pw0[1]=PKW(P0,2), pw0); \
    VRD(4); SBAR(); GAPA(C1=__builtin_amdgcn_mfma_f32_32x32x16_bf16(kf[1],qr[0],f32x16{},0,0,0), P0[6],P0[7],P0[8],P0[9],     pw0[2]=PKW(P0,4), pw0[3]=PKW(P0,6), pw0); \
    VRD(1); SBAR(); GAPA(C0=__builtin_amdgcn_mfma_f32_32x32x16_bf16(kf[2],qr[1],C0,0,0,0),   P0[10],P0[11],P0[12],P0[13], pw1[0]=PKW(P0,8), pw1[1]=PKW(P0,10), pw1); \
    VRD(5); SBAR(); GAPA(C1=__builtin_amdgcn_mfma_f32_32x32x16_bf16(kf[3],qr[1],C1,0,0,0),   P0[14],P0[15],P1[0],P1[1],   pw1[2]=PKW(P0,12),pw1[3]=PKW(P0,14), pw1); \
    VRD(2); SBAR(); GAPA(C0=__builtin_amdgcn_mfma_f32_32x32x16_bf16(kf[4],qr[2],C0,0,0,0),   P1[2],P1[3],P1[4],P1[5],     pw2[0]=PKW(P1,0), pw2[1]=PKW(P1,2), pw2); \
    VRD(6); SBAR(); GAPA(C1=__builtin_amdgcn_mfma_f32_32x32x16_bf16(kf[5],qr[2],C1,0,0,0),   P1[6],P1[7],P1[8],P1[9],     pw2[2]=PKW(P1,4), pw2[3]=PKW(P1,6), pw2); \
    VRD(3); SBAR(); GAPA(C0=__builtin_amdgcn_mfma_f32_32x32x16_bf16(kf[6],qr[3],C0,0,0,0),   P1[10],P1[11],P1[12],P1[13], pw3[0]=PKW(P1,8), pw3[1]=PKW(P1,10), pw3); \
    VRD(7); SBAR(); GAPA(C1=__builtin_amdgcn_mfma_f32_32x32x16_bf16(kf[7],qr[3],C1,0,0,0),   P1[14],P1[15],0.f,0.f,       pw3[2]=PKW(P1,12),pw3[3]=PKW(P1,14), pw3); \
    l_reg+=sacc; \
    if(GK){DMA_K((t)+3,sl_cur);} if(GV){DMA_V((t)+1,sl_next);} \
    _Pragma("unroll") for(int r=0;r<16;++r){C0[r]-=mhat;C1[r]-=mhat;} \
    CMASK(C0,C1,t); \
    { float a=MX3(C0[0],C0[1],C1[0]),b=MX3(C0[2],C0[3],C1[1]); a=MX3(a,C1[2],C1[3]); \
      _Pragma("unroll") for(int r=4;r<16;r+=4){a=MX3(a,C0[r],C0[r+1]);b=MX3(b,C0[r+2],C0[r+3]);a=MX3(a,C1[r],C1[r+1]);b=MX3(b,C1[r+2],C1[r+3]);} \
      float rm=__builtin_fmaxf(a,b); { auto rr=__builtin_amdgcn_permlane32_swap(__float_as_uint(rm),__float_as_uint(rm),false,false); rm=__builtin_fmaxf(__uint_as_float(rr[0]),__uint_as_float(rr[1])); } \
      resc=false; \
      if(__builtin_expect(__any(rm>(float)THRL),0)){ const float dl=__builtin_fmaxf(rm,0.f); mhat+=dl; \
        _Pragma("unroll") for(int r=0;r<16;++r){C0[r]-=dl;C1[r]-=dl;} \
        const float f=__builtin_amdgcn_exp2f(-dl); l_reg*=f; if(hi==0)wsf[r32]=f; resc=true; } } \
    SBAR(); \
    GAPB(o[0]=__builtin_amdgcn_mfma_f32_32x32x16_bf16(PAF(0),VFR(0),o[0],0,0,0), C0,0); \
    GAPB(o[1]=__builtin_amdgcn_mfma_f32_32x32x16_bf16(PAF(0),VFR(4),o[1],0,0,0), C0,4); \
    KRD(GL,0); GAPB(o[0]=__builtin_amdgcn_mfma_f32_32x32x16_bf16(PAF(1),VFR(1),o[0],0,0,0), C0,8); \
    KRD(GL,1); GAPB(o[1]=__builtin_amdgcn_mfma_f32_32x32x16_bf16(PAF(1),VFR(5),o[1],0,0,0), C0,12); \
    KRD(GL,2); GAPB(o[0]=__builtin_amdgcn_mfma_f32_32x32x16_bf16(PAF(2),VFR(2),o[0],0,0,0), C1,0); \
    KRD(GL,3); GAPB(o[1]=__builtin_amdgcn_mfma_f32_32x32x16_bf16(PAF(2),VFR(6),o[1],0,0,0), C1,4); \
    GAPB(o[0]=__builtin_amdgcn_mfma_f32_32x32x16_bf16(PAF(3),VFR(3),o[0],0,0,0), C1,8); \
    GAPB(o[1]=__builtin_amdgcn_mfma_f32_32x32x16_bf16(PAF(3),VFR(7),o[1],0,0,0), C1,12); \
    }while(0)
  int t=1;
  #undef CMASK
  #define CMASK(P0,P1,t) do{}while(0)
  for(;t+5<NT;t+=2){
    STEP(pB0,pB1,pA0,pA1,t,true,true,true);     WAIT_BAR(2); RESC(); ROT();
    STEP(pA0,pA1,pB0,pB1,t+1,true,true,true);   WAIT_BAR(2); RESC(); ROT();
  }
  #undef CMASK
  #define CMASK(P0,P1,t) do{int jb_=(t)-(NT-4); if(jb_>=0)cmask(P0,P1,jb_,qrel,hi);}while(0)
  #define ENDW(tt) do{ if((tt)+3<NT){WAIT_BAR(2);} else if((tt)+2<NT){WAIT_BAR(1);} else {WAIT_BAR(0);} }while(0)
  for(;t+1<NT;t+=2){
    STEP(pB0,pB1,pA0,pA1,t,(t+3<NT),(t+1<NT),(t+1<NT));       ENDW(t);   RESC(); ROT();
    STEP(pA0,pA1,pB0,pB1,t+1,(t+4<NT),(t+2<NT),(t+2<NT));     ENDW(t+1); RESC(); ROT();
  }
  STEP(pB0,pB1,pA0,pA1,NT-1,false,false,false); RESC();
  { float sacc=pB0[0]+pB0[1]; _Pragma("unroll") for(int r=2;r<16;++r)sacc+=pB0[r]; _Pragma("unroll") for(int r=0;r<16;++r)sacc+=pB1[r]; l_reg+=sacc;
    pw0=(u32x4){PKW(pB0,0),PKW(pB0,2),PKW(pB0,4),PKW(pB0,6)};pw1=(u32x4){PKW(pB0,8),PKW(pB0,10),PKW(pB0,12),PKW(pB0,14)};pw2=(u32x4){PKW(pB1,0),PKW(pB1,2),PKW(pB1,4),PKW(pB1,6)};pw3=(u32x4){PKW(pB1,8),PKW(pB1,10),PKW(pB1,12),PKW(pB1,14)};
    SBAR(); const int vb0=(int)(lds0+LDS_V)+((lane>>4)&1)*32+(lane&3)*8+(4*hi+((lane&15)>>2))*64; pv(o,vb0+sl_cur,PAF(0),PAF(1),PAF(2),PAF(3)); }
  #undef PKW
  #undef PAF
  #undef VFR
  #undef PIN
  #undef MX3
  #undef GAPA
  #undef GAPB
  #undef EX
  #undef VRD
  #undef KRD
  #undef STEP
  #undef ENDW
  {auto rr=__builtin_amdgcn_permlane32_swap(__float_as_uint(l_reg),__float_as_uint(l_reg),false,false);l_reg=__uint_as_float(rr[0])+__uint_as_float(rr[1]);}
  if(hi==0)wsf[32+r32]=l_reg;asm volatile("s_waitcnt lgkmcnt(0)":::"memory");
  float rli[16];
  #pragma unroll
  for(int r=0;r<16;++r)rli[r]=__builtin_amdgcn_rcpf(wsf[32+crow(r,hi)]);
  bf16h*Ow=O+((long)(combo>>5)*4096+q0+wid*QBLK)*OPITCH+((2*((combo>>2)&7)+((combo>>1)&1))*2+(combo&1))*D;
  { bf16h*stg=(bf16h*)(shm+LDS_OST)+wid*2048;
    #pragma unroll
    for(int r=0;r<16;++r){const int orow=crow(r,hi);
      #pragma unroll
      for(int d0=0;d0<2;++d0)stg[orow*64+d0*32+r32]=__float2bfloat16(o[d0][r]*rli[r]);}
    asm volatile("s_waitcnt lgkmcnt(0)":::"memory");
    #pragma unroll
    for(int i=0;i<4;++i){const int row=i*8+(lane>>3),ch=lane&7; const u32x4 v=*(const u32x4*)(stg+row*64+ch*8); ATTN_STORE16(Ow+(long)row*OPITCH+ch*8,v);} }
  asm volatile("s_waitcnt lgkmcnt(0)\n\ts_barrier":::"memory");
  #undef DMA_K
  #undef DMA_V
  #undef CMASK
  #undef START
  #undef RESC
  #undef ROT
}
constexpr int ATTN_LDS_BYTES=LDS_BYTES;
#undef SBAR
#undef WAIT_BAR
}


namespace dattn {
using bf16h = __hip_bfloat16;
using bf16x8 = __attribute__((ext_vector_type(8))) short;
using s16x4 = __attribute__((ext_vector_type(4))) short;
using f32x16 = __attribute__((ext_vector_type(16))) float;
using u32x4 = __attribute__((ext_vector_type(4))) unsigned;
using f32x4v = __attribute__((ext_vector_type(4))) float;
constexpr int PITCH = 1024, KSLOT = 16384, VSLOT = 16384, LDS_K = 0, LDS_V = 3 * KSLOT, LDS_WS = LDS_V + 3 * VSLOT, LDS_END = LDS_WS + 8 * 256;
constexpr int LDS_X = 0, LDS_OST = 65536;
static_assert(LDS_END <= 131072 && LDS_OST + 4 * 8192 <= LDS_WS, "dattn LDS map");
typedef __attribute__((address_space(3))) const char* lds_cptr;
typedef short v4i16_t __attribute__((ext_vector_type(4)));
__device__ __forceinline__ int crow(int r, int hi) { return (r & 3) + 8 * (r >> 2) + 4 * hi; }
__device__ __forceinline__ void glds16(const void* gsrc, unsigned lds_dst) { unsigned keep;
    asm volatile("s_mov_b32 %0, m0\n\ts_mov_b32 m0, %2\n\ts_nop 0\n\tglobal_load_lds_dwordx4 %1, off\n\ts_mov_b32 m0, %0" : "=&s"(keep) : "v"(gsrc), "s"(lds_dst) : "memory"); }
__device__ __forceinline__ void glds16s(const void* sbase, unsigned voff, unsigned lds_dst) { unsigned keep;
    asm volatile("s_mov_b32 %0, m0\n\ts_mov_b32 m0, %3\n\ts_nop 0\n\tglobal_load_lds_dwordx4 %1, %2\n\ts_mov_b32 m0, %0" : "=&s"(keep) : "v"(voff), "s"(sbase), "s"(lds_dst) : "memory"); }
__device__ __forceinline__ s16x4 vtr(lds_cptr p) { return __builtin_bit_cast(s16x4, __builtin_amdgcn_ds_read_tr16_b64_v4i16((__attribute__((address_space(3))) v4i16_t*)p)); }
__device__ __forceinline__ unsigned cvtpk(float lo, float hi) { return cvt_pk_bf16(lo, hi); }
__device__ __forceinline__ float xhalf_max(float m) { auto rr = __builtin_amdgcn_permlane32_swap(__float_as_uint(m), __float_as_uint(m), false, false); return fmaxf(__uint_as_float(rr[0]), __uint_as_float(rr[1])); }
__device__ __forceinline__ float xhalf_sum(float m) { auto rr = __builtin_amdgcn_permlane32_swap(__float_as_uint(m), __float_as_uint(m), false, false); return __uint_as_float(rr[0]) + __uint_as_float(rr[1]); }
#define DA_WAIT_BAR(N) asm volatile("s_waitcnt vmcnt(" #N ") lgkmcnt(0)\n\ts_barrier" ::: "memory")

template <int THRL>
__device__ __forceinline__ void unit(int bh, int qb, const bf16h* Q, const bf16h* __restrict__ K, const bf16h* __restrict__ V, bf16h* O, float lam, const f32x4v gA, const f32x4v gB, char* shm) {
    int tid_ = threadIdx.x; asm volatile("" : "+v"(tid_));
    const int tid = tid_, lane = tid & 63, r32 = lane & 31, hi = lane >> 5; const int wid = __builtin_amdgcn_readfirstlane(tid >> 6);
    const int comp = wid >> 2, wq = wid & 3, h = bh & 7; const long rowbase = (long)(bh >> 3) * 4096; const int q0 = qb * 128;
    const bf16h* Qw = Q + (rowbase + q0 + wq * 32) * PITCH + (2 * h + comp) * 64;
    const unsigned lds0 = (unsigned)(uintptr_t)shm;
    const lds_cptr shm3 = (lds_cptr)shm;
    __attribute__((address_space(3))) float* wsf = (__attribute__((address_space(3))) float*)(shm3 + LDS_WS) + wid * 64;
    const bf16h* ksrc = K + rowbase * PITCH + (2 * h) * 64 + wid * 8;
    const bf16h* vsrc = V + rowbase * PITCH + h * 128 + (long)(16 * (wid & 3)) * PITCH + (wid >> 2) * 32;
    const unsigned kvoff = (unsigned)lane * PITCH * 2u, vvoff = ((unsigned)(lane >> 2) * PITCH + (unsigned)(lane & 3) * 8u) * 2u;
    const unsigned kdst = lds0 + LDS_K + wid * 1024, vdst = lds0 + LDS_V + wid * 1024;
#define DA_DMA_K(t, slot) do { glds16s(ksrc + (long)(t) * 64 * PITCH, kvoff, (unsigned)__builtin_amdgcn_readfirstlane(kdst + (slot))); glds16s(ksrc + (long)(t) * 64 * PITCH + 64, kvoff, (unsigned)__builtin_amdgcn_readfirstlane(kdst + (slot) + 8192)); } while (0)
#define DA_DMA_V(t, slot) do { glds16s(vsrc + (long)(t) * 64 * PITCH, vvoff, (unsigned)__builtin_amdgcn_readfirstlane(vdst + (slot))); glds16s(vsrc + (long)(t) * 64 * PITCH + 64, vvoff, (unsigned)__builtin_amdgcn_readfirstlane(vdst + (slot) + 8192)); } while (0)
    const lds_cptr kp0 = shm3 + LDS_K + comp * 8192 + hi * 1024 + r32 * 16;
    const lds_cptr vp0 = shm3 + LDS_V + ((lane >> 4) & 1) * 32 + (lane & 3) * 8 + (4 * hi + ((lane & 15) >> 2)) * 64;
    const int NT = (q0 + 128) / 64;
    bf16x8 qr[4];
#pragma unroll
    for (int d0 = 0; d0 < 4; ++d0) qr[d0] = *reinterpret_cast<const bf16x8*>(&Qw[(long)r32 * PITCH + d0 * 16 + hi * 8]);
    DA_DMA_K(0, 0); DA_DMA_V(0, 0); DA_DMA_K(1, KSLOT);
    float l_reg = 0.f; f32x16 o[4];
#pragma unroll
    for (int d = 0; d < 4; ++d)
#pragma unroll
        for (int r = 0; r < 16; ++r) o[d][r] = 0.f;
    u32x4 pw0 = {0u, 0u, 0u, 0u}, pw1 = pw0, pw2 = pw0, pw3 = pw0;
    const int qrel = wq * 32 + r32;
    int ks_cur = 0, ks_n2 = 2 * KSLOT;
    int vs_cur = 0, vs_n1 = VSLOT, vs_prev = 2 * VSLOT;
#define DA_SB() __builtin_amdgcn_sched_barrier(0)
#define DA_KRD() do { const lds_cptr kp = kp0 + ks_cur; \
        _Pragma("unroll") for (int d0 = 0; d0 < 4; ++d0) { kf[2 * d0] = *(const __attribute__((address_space(3))) bf16x8*)(kp + d0 * 2048); kf[2 * d0 + 1] = *(const __attribute__((address_space(3))) bf16x8*)(kp + d0 * 2048 + 512); } DA_SB(); } while (0)
#define DA_QK(t) do { \
        p0 = __builtin_amdgcn_mfma_f32_32x32x16_bf16(kf[0], qr[0], f32x16{}, 0, 0, 0); p1 = __builtin_amdgcn_mfma_f32_32x32x16_bf16(kf[1], qr[0], f32x16{}, 0, 0, 0); \
        _Pragma("unroll") for (int d0 = 1; d0 < 4; ++d0) { p0 = __builtin_amdgcn_mfma_f32_32x32x16_bf16(kf[2 * d0], qr[d0], p0, 0, 0, 0); p1 = __builtin_amdgcn_mfma_f32_32x32x16_bf16(kf[2 * d0 + 1], qr[d0], p1, 0, 0, 0); } \
        DA_SB(); \
        const int jb = (t) - (NT - 2); \
        if (jb >= 0) { const int kb = 64 * jb + 4 * hi; \
            _Pragma("unroll") for (int r = 0; r < 16; ++r) { const int kv = kb + (r & 3) + 8 * (r >> 2); if (kv > qrel) p0[r] = -INFINITY; if (kv + 32 > qrel) p1[r] = -INFINITY; } } } while (0)
#define DA_SOFTMAX(t) do { \
        float rm = fmaxf(p0[0], p1[0]); \
        _Pragma("unroll") for (int r = 1; r < 16; ++r) rm = fmaxf(rm, fmaxf(p0[r], p1[r])); \
        rm = xhalf_max(rm); \
        if ((t) == 0) { mhat = rm; } \
        else if (__any(rm > mhat + (float)THRL)) { const float dl = fmaxf(rm - mhat, 0.f); mhat += dl; const float f = __builtin_amdgcn_exp2f(-dl); l_reg *= f; \
            if (hi == 0) wsf[r32] = f; asm volatile("s_waitcnt lgkmcnt(0)" ::: "memory"); \
            _Pragma("unroll") for (int g4 = 0; g4 < 4; ++g4) { const f32x4v fv = *(const __attribute__((address_space(3))) f32x4v*)(wsf + 8 * g4 + 4 * hi); \
                _Pragma("unroll") for (int d = 0; d < 4; ++d) { o[d][4 * g4] *= fv[0]; o[d][4 * g4 + 1] *= fv[1]; o[d][4 * g4 + 2] *= fv[2]; o[d][4 * g4 + 3] *= fv[3]; } } } \
        float sacc = 0.f; \
        _Pragma("unroll") for (int r = 0; r < 16; ++r) { p0[r] = __builtin_amdgcn_exp2f(p0[r] - mhat); p1[r] = __builtin_amdgcn_exp2f(p1[r] - mhat); sacc += p0[r] + p1[r]; } \
        l_reg += sacc; \
        pw0 = (u32x4){cvtpk(p0[0], p0[1]), cvtpk(p0[2], p0[3]), cvtpk(p0[4], p0[5]), cvtpk(p0[6], p0[7])}; pw1 = (u32x4){cvtpk(p0[8], p0[9]), cvtpk(p0[10], p0[11]), cvtpk(p0[12], p0[13]), cvtpk(p0[14], p0[15])}; \
        pw2 = (u32x4){cvtpk(p1[0], p1[1]), cvtpk(p1[2], p1[3]), cvtpk(p1[4], p1[5]), cvtpk(p1[6], p1[7])}; pw3 = (u32x4){cvtpk(p1[8], p1[9]), cvtpk(p1[10], p1[11]), cvtpk(p1[12], p1[13]), cvtpk(p1[14], p1[15])}; DA_SB(); } while (0)
#define DA_VRD(VF, vslot, g) do { const lds_cptr vp = vp0 + (vslot) + (g) * 8192; \
        _Pragma("unroll") for (int i = 0; i < 8; ++i) { VF[2 * i] = vtr(vp + (i >> 2) * 4096 + (i & 3) * 1024); VF[2 * i + 1] = vtr(vp + (i >> 2) * 4096 + (i & 3) * 1024 + 512); } DA_SB(); } while (0)
#define DA_PVM(VF, g) do { \
        _Pragma("unroll") for (int i = 0; i < 8; ++i) { const s16x4 lo = VF[2 * i], hi4 = VF[2 * i + 1]; \
            const bf16x8 vf = (bf16x8){lo[0], lo[1], lo[2], lo[3], hi4[0], hi4[1], hi4[2], hi4[3]}; \
            const bf16x8 pa = __builtin_bit_cast(bf16x8, (i & 3) == 0 ? pw0 : (i & 3) == 1 ? pw1 : (i & 3) == 2 ? pw2 : pw3); \
            o[2 * (g) + (i >> 2)] = __builtin_amdgcn_mfma_f32_32x32x16_bf16(pa, vf, o[2 * (g) + (i >> 2)], 0, 0, 0); } DA_SB(); } while (0)
    bf16x8 kf[8]; s16x4 vfa[16], vfb[16];
    f32x16 p0, p1;
#define DA_STEP(t, HASPV) do { \
        if ((t) + 1 < NT) { DA_WAIT_BAR(2); } else { DA_WAIT_BAR(0); }            \
        const bool gv = (t) + 1 < NT, gk = (t) + 2 < NT; \
        DA_KRD(); \
        if (HASPV) DA_VRD(vfa, vs_prev, 0); \
        if (gv) glds16s(vsrc + (long)((t) + 1) * 64 * PITCH, vvoff, (unsigned)__builtin_amdgcn_readfirstlane(vdst + vs_n1)); \
        DA_QK(t); \
        if (HASPV) DA_VRD(vfb, vs_prev, 1); \
        if (gv) glds16s(vsrc + (long)((t) + 1) * 64 * PITCH + 64, vvoff, (unsigned)__builtin_amdgcn_readfirstlane(vdst + vs_n1 + 8192)); \
          \
        if (gk) glds16s(ksrc + (long)((t) + 2) * 64 * PITCH, kvoff, (unsigned)__builtin_amdgcn_readfirstlane(kdst + ks_n2)); \
        DA_SB(); \
          \
        if (HASPV) { \
            _Pragma("unroll") for (int i = 0; i < 8; ++i) { const s16x4 lo = vfa[2 * i], hi4 = vfa[2 * i + 1]; const bf16x8 vf = (bf16x8){lo[0], lo[1], lo[2], lo[3], hi4[0], hi4[1], hi4[2], hi4[3]}; \
                const bf16x8 pa = __builtin_bit_cast(bf16x8, (i & 3) == 0 ? pw0 : (i & 3) == 1 ? pw1 : (i & 3) == 2 ? pw2 : pw3); o[i >> 2] = __builtin_amdgcn_mfma_f32_32x32x16_bf16(pa, vf, o[i >> 2], 0, 0, 0); } \
            _Pragma("unroll") for (int i = 0; i < 8; ++i) { const s16x4 lo = vfb[2 * i], hi4 = vfb[2 * i + 1]; const bf16x8 vf = (bf16x8){lo[0], lo[1], lo[2], lo[3], hi4[0], hi4[1], hi4[2], hi4[3]}; \
                const bf16x8 pa = __builtin_bit_cast(bf16x8, (i & 3) == 0 ? pw0 : (i & 3) == 1 ? pw1 : (i & 3) == 2 ? pw2 : pw3); o[2 + (i >> 2)] = __builtin_amdgcn_mfma_f32_32x32x16_bf16(pa, vf, o[2 + (i >> 2)], 0, 0, 0); } } \
        float sacc = 0.f; \
        _Pragma("unroll") for (int r = 0; r < 16; ++r) { p0[r] = __builtin_amdgcn_exp2f(p0[r]); p1[r] = __builtin_amdgcn_exp2f(p1[r]); sacc += p0[r] + p1[r]; } \
        if (HASPV) { _Pragma("unroll") for (int i = 0; i < 16; ++i) { __builtin_amdgcn_sched_group_barrier(0x008, 1, 0); __builtin_amdgcn_sched_group_barrier(0x002, 6, 0); } } \
        DA_SB(); \
        if (gk) glds16s(ksrc + (long)((t) + 2) * 64 * PITCH + 64, kvoff, (unsigned)__builtin_amdgcn_readfirstlane(kdst + ks_n2 + 8192)); \
        l_reg += sacc; \
        pw0 = (u32x4){cvtpk(p0[0], p0[1]), cvtpk(p0[2], p0[3]), cvtpk(p0[4], p0[5]), cvtpk(p0[6], p0[7])}; pw1 = (u32x4){cvtpk(p0[8], p0[9]), cvtpk(p0[10], p0[11]), cvtpk(p0[12], p0[13]), cvtpk(p0[14], p0[15])}; \
        pw2 = (u32x4){cvtpk(p1[0], p1[1]), cvtpk(p1[2], p1[3]), cvtpk(p1[4], p1[5]), cvtpk(p1[6], p1[7])}; pw3 = (u32x4){cvtpk(p1[8], p1[9]), cvtpk(p1[10], p1[11]), cvtpk(p1[12], p1[13]), cvtpk(p1[14], p1[15])}; \
        DA_SB(); \
        { const int k_ = ks_cur; ks_cur = (ks_cur == 2 * KSLOT) ? 0 : ks_cur + KSLOT; ks_n2 = k_; }     \
        { vs_prev = vs_cur; vs_cur = vs_n1; vs_n1 = (vs_n1 == 2 * VSLOT) ? 0 : vs_n1 + VSLOT; } } while (0)
    DA_STEP(0, false);
    for (int t = 1; t < NT; ++t) DA_STEP(t, true);
#undef DA_STEP
    { DA_VRD(vfa, vs_prev, 0); DA_VRD(vfb, vs_prev, 1); DA_PVM(vfa, 0); DA_PVM(vfb, 1); }
    { const float lt = xhalf_sum(l_reg); if (hi == 0) wsf[r32] = 1.0f / lt; asm volatile("s_waitcnt lgkmcnt(0)" ::: "memory");
#pragma unroll
      for (int g4 = 0; g4 < 4; ++g4) { const f32x4v fv = *(const __attribute__((address_space(3))) f32x4v*)(wsf + 8 * g4 + 4 * hi);
#pragma unroll
          for (int d = 0; d < 4; ++d) { o[d][4 * g4] *= fv[0]; o[d][4 * g4 + 1] *= fv[1]; o[d][4 * g4 + 2] *= fv[2]; o[d][4 * g4 + 3] *= fv[3]; } } }
    DA_WAIT_BAR(0);
    __attribute__((address_space(3))) float* X = (__attribute__((address_space(3))) float*)(shm3 + LDS_X) + wq * 4096 + lane;
    if (comp == 1) {
#pragma unroll
        for (int r = 0; r < 16; ++r)
#pragma unroll
            for (int d = 0; d < 4; ++d) X[(r * 4 + d) * 64] = o[d][r];
    }
    DA_WAIT_BAR(0);
    if (comp == 0) {
        __attribute__((address_space(3))) unsigned short* stg = (__attribute__((address_space(3))) unsigned short*)(shm3 + LDS_OST) + wq * 4096;
#pragma unroll
        for (int r = 0; r < 16; ++r) { const int orow = crow(r, hi);
#pragma unroll
            for (int d = 0; d < 4; ++d) { const float a = o[d][r] - lam * X[(r * 4 + d) * 64]; stg[orow * 128 + d * 32 + r32] = (unsigned short)(cvtpk(a, 0.f) & 0xffffu); } }
        asm volatile("s_waitcnt lgkmcnt(0)" ::: "memory");
        bf16h* Ow = O + (rowbase + q0 + wq * 32) * PITCH + h * 128;
        const int ch = lane & 15;
#pragma unroll
        for (int i = 0; i < 8; ++i) { const int row = i * 4 + (lane >> 4);
            const u32x4 v = *(const __attribute__((address_space(3))) u32x4*)(stg + row * 128 + ch * 8);
            float a[8];
#pragma unroll
            for (int j = 0; j < 4; ++j) { a[2 * j] = __uint_as_float(v[j] << 16); a[2 * j + 1] = __uint_as_float(v[j] & 0xffff0000u); }
            float ss = 0.f;
#pragma unroll
            for (int j = 0; j < 8; ++j) ss += a[j] * a[j];
            ss = sum_lanes16(ss);
            const float rs = rsqrtf(ss * (1.0f / 128.0f) + 1e-6f);
            u32x4 w; w[0] = cvtpk(a[0] * rs * gA[0], a[1] * rs * gA[1]); w[1] = cvtpk(a[2] * rs * gA[2], a[3] * rs * gA[3]); w[2] = cvtpk(a[4] * rs * gB[0], a[5] * rs * gB[1]); w[3] = cvtpk(a[6] * rs * gB[2], a[7] * rs * gB[3]);
            *(u32x4*)(Ow + (long)row * PITCH + ch * 8) = w; }
    }
    DA_WAIT_BAR(0);
#undef DA_DMA_K
#undef DA_DMA_V
#undef DA_QK
#undef DA_SOFTMAX
#undef DA_PVM
#undef DA_VRD
#undef DA_KRD
#undef DA_SB
}
#undef DA_WAIT_BAR
}

constexpr size_t MiB = 1u << 20;
constexpr size_t WS_CTL = 0, CTL_ZERO_BYTES = 1 * MiB;
constexpr size_t WS_MODF = 1 * MiB;
constexpr size_t WS_LAM = 1 * MiB + 512 * 1024;
constexpr size_t WS_BGUP = 2 * MiB;
constexpr size_t WS_RWT = 3 * MiB;
constexpr size_t WS_ROPE = 4 * MiB;
constexpr size_t WS_WQKV = 12 * MiB, WS_WO = 18 * MiB, WS_WML = 20 * MiB, WS_WMLO = 27 * MiB;
constexpr size_t WS_TOKE = 29 * MiB, WS_GATE = 30 * MiB, WS_LIST = 31 * MiB, WS_IG = 35 * MiB, WS_LF = 36 * MiB;
constexpr size_t WS_SSQ = 37 * MiB;
constexpr size_t WS_WGU = 64 * MiB, WS_WDN = 320 * MiB;
constexpr size_t WS_H = 448 * MiB, WS_Q = 512 * MiB, WS_K = 576 * MiB, WS_V = 640 * MiB;
constexpr size_t WS_MQ = 512 * MiB, WS_MK = 544 * MiB, WS_MV = 576 * MiB, WS_MO = 640 * MiB;
constexpr size_t WS_OB = 704 * MiB, WS_ATTC = 832 * MiB, WS_X1 = 896 * MiB, WS_X2 = 1024 * MiB;
constexpr size_t WS_ACT = 1152 * MiB, WS_Y = 1424 * MiB, WS_END = 1696 * MiB;
static_assert(WS_ACT + (size_t)MAXMT * 256 * 1024 * 2 <= WS_Y && WS_Y + (size_t)MAXMT * 256 * 1024 * 2 <= WS_END, "ws map");
constexpr size_t WS_CTS = WS_OB, WS_NS = WS_OB + 8 * MiB, WS_GS = WS_OB + 9 * MiB;
constexpr int CW_TMO = 0, CW_BAR = 4096, CW_CNT = 8192;

constexpr int RING_BYTES = 131072;
constexpr int LDSCTL_OFF = RING_BYTES;
constexpr int LT_MISC = 0;
constexpr int LT_CNT = 64, LT_TSTART = 64 + 32 * 4, LT_TILEE = 64 + 32 * 4 + 36 * 4;
constexpr int LDS_BYTES = 163840;
static_assert(LT_TILEE + MAXMT * 4 <= LDS_BYTES - LDSCTL_OFF, "LDS tables");

#define XB_TMO      128
#define XB_XCNT(j)  (256  + 64 * (j))
#define XB_XSUB(j)  (1280 + 64 * (j))
#define XB_XGEN(j)  (2304 + 64 * (j))
#define XB_TOP      3328
#define XB_TOPGEN   3392
#define XCD_BAR_WORDS 3456
#define XB_SPIN_CAP (1u << 18)
__device__ __forceinline__ unsigned xb_ld(unsigned* p)              { return __hip_atomic_load(p, __ATOMIC_RELAXED, __HIP_MEMORY_SCOPE_AGENT); }
__device__ __forceinline__ unsigned xb_add(unsigned* p, unsigned v) { return __hip_atomic_fetch_add(p, v, __ATOMIC_RELAXED, __HIP_MEMORY_SCOPE_AGENT); }
__device__ __forceinline__ unsigned xb_xcc_id() { return (unsigned)__builtin_amdgcn_s_getreg((3 << 11) | 20) & 0xFu; }
#define XB_SPIN(cond, bar) do { unsigned _sp = 0; while (cond) { __builtin_amdgcn_s_sleep(1); \
    if ((++_sp & 255u) == 0u) { if (xb_ld(&(bar)[XB_TMO])) break; if (_sp > XB_SPIN_CAP) { atomicAdd(&(bar)[XB_TMO], 1u); break; } } } } while (0)
struct XcdBarrier { unsigned* bar; unsigned x; volatile LAS unsigned* st; };
__device__ __forceinline__ XcdBarrier xcd_barrier_post(unsigned* bar, volatile LAS unsigned* st) {
    XcdBarrier b; b.bar = bar; b.x = xb_xcc_id(); b.st = st;
    if (threadIdx.x == 0) (void)xb_add(&bar[XB_XCNT(b.x)], 1u);
    return b;
}
__device__ __forceinline__ void xcd_barrier_complete(unsigned* bar, unsigned x, unsigned& nloc, unsigned& nx) {
    const unsigned G = gridDim.x * gridDim.y * gridDim.z;
    unsigned sum, cnt, mine, sp = 0u;
    for (;;) {
        sum = 0u; cnt = 0u; mine = 0u;
#pragma unroll
        for (unsigned j = 0; j < 16; ++j) { const unsigned c = xb_ld(&bar[XB_XCNT(j)]); sum += c; cnt += (c > 0u) ? 1u : 0u; mine = (j == x) ? c : mine; }
        if (sum == G) break;
        __builtin_amdgcn_s_sleep(1);
        if ((++sp & 255u) == 0u) { if (xb_ld(&bar[XB_TMO])) break; if (sp > XB_SPIN_CAP) { atomicAdd(&bar[XB_TMO], 1u); break; } }
    }
    nloc = mine > 0u ? mine : 1u; nx = cnt > 0u ? cnt : 1u;
}
__device__ __forceinline__ void xcd_barrier(const XcdBarrier& b) {
    asm volatile("s_waitcnt vmcnt(0)" ::: "memory");
    __syncthreads();
    if (threadIdx.x == 0) {
        unsigned* bar = b.bar;
        __builtin_amdgcn_s_waitcnt(0);
        unsigned nloc = b.st[0], nx = b.st[1];
        if (nloc == 0u) { xcd_barrier_complete(bar, b.x, nloc, nx); b.st[0] = nloc; b.st[1] = nx; }
        const unsigned old = xb_add(&bar[XB_XSUB(b.x)], 1u);
        const unsigned gen = old / nloc;
        if (old + 1u == (gen + 1u) * nloc) {
            __builtin_amdgcn_fence(__ATOMIC_RELEASE, "agent");
            asm volatile("s_waitcnt vmcnt(0)" ::: "memory");
            const unsigned og = xb_add(&bar[XB_TOP], 1u);
            const unsigned tg = og / nx;
            if (og + 1u == (tg + 1u) * nx) xb_add(&bar[XB_TOPGEN], 1u);
            else XB_SPIN(xb_ld(&bar[XB_TOPGEN]) == tg, bar);
            __builtin_amdgcn_fence(__ATOMIC_ACQUIRE, "agent");
            xb_add(&bar[XB_XGEN(b.x)], 1u);
            asm volatile("s_waitcnt vmcnt(0)" ::: "memory");
        } else {
            XB_SPIN(xb_ld(&bar[XB_XGEN(b.x)]) == gen, bar);
            __builtin_amdgcn_fence(__ATOMIC_ACQUIRE, "agent");
            asm volatile("s_waitcnt vmcnt(0)" ::: "memory");
        }
    }
    __syncthreads();
}

struct Params {
    const float* in[27];
    float* out;
    unsigned char* ws;
    float invf[32];
};
enum { I_X = 0, I_C, I_POS, I_ADAW, I_ADAB, I_MIXN, I_FFNN, I_AWIN, I_AWOUT, I_AQN, I_AKN, I_LQ1, I_LK1, I_LQ2, I_LK2, I_ASUB,
       I_MWIN, I_MBI, I_MBF, I_MON, I_MWOUT, I_RW, I_RB, I_WGU, I_BGU, I_WDN, I_BDN };

template <bool F8Q> struct EpiQKV {
    static constexpr float SC = F8Q ? WSCALE_INV : 1.0f;
    bf16 *Q, *K, *V; const float* rope; const float *qg, *kg;
    __device__ __forceinline__ void prefetch(pg8::EpiPre& p, const pg8::Unit& u, int wr, int wc, int fr, int fq) const {
        const float* gn = u.pn < 4 ? qg : kg;
#pragma unroll
        for (int bj = 0; bj < 2; ++bj)
#pragma unroll
            for (int n = 0; n < 2; ++n) p.v[2 * bj + n] = *(const f32x4*)(gn + 32 * bj + 8 * fq + 4 * n);
    }
    __device__ __forceinline__ void operator()(const f32x4 (&acc)[2][2][4][2], const pg8::Unit& u, int wr, int wc, int fr, int fq, const pg8::EpiPre& pre) const {
        const int row0 = u.pm * 256 + wr * 64 + fr;
        if (u.pn < 8) {
            const bool isq = u.pn < 4; bf16* base = isq ? Q : K; const float osc = isq ? C2Q : 1.0f;
            const int vec = (u.pn & 3) * 4 + wc;
            f32x4 g[2][2];
#pragma unroll
            for (int bj = 0; bj < 2; ++bj)
#pragma unroll
                for (int n = 0; n < 2; ++n) g[bj][n] = pre.v[2 * bj + n];
#pragma unroll
            for (int ai = 0; ai < 2; ++ai)
#pragma unroll
                for (int m = 0; m < 4; ++m) {
                    const int row = row0 + ai * 128 + m * 16;
                    float ss = 0.f;
#pragma unroll
                    for (int bj = 0; bj < 2; ++bj)
#pragma unroll
                        for (int n = 0; n < 2; ++n) { const f32x4 x = acc[ai][bj][m][n]; ss += (x[0] * x[0] + x[1] * x[1]) + (x[2] * x[2] + x[3] * x[3]); }
                    ss = sum_fq4(ss);
                    const float rs = rsqrtf(ss * (SC * SC / 64.0f) + RMS_EPS) * (SC * osc);
                    const bf16* rp = (const bf16*)rope + (size_t)row * 64 + 8 * fq;
                    const v4u csw = *(const v4u*)rp, snw = *(const v4u*)(rp + 32);
                    v4u w1, w2;
#pragma unroll
                    for (int n = 0; n < 2; ++n) {
                        const f32x4 cs = {bf_lo(csw[2 * n]), bf_hi(csw[2 * n]), bf_lo(csw[2 * n + 1]), bf_hi(csw[2 * n + 1])}, sn = {bf_lo(snw[2 * n]), bf_hi(snw[2 * n]), bf_lo(snw[2 * n + 1]), bf_hi(snw[2 * n + 1])};
                        const f32x4 y1 = acc[ai][0][m][n] * rs * g[0][n], y2 = acc[ai][1][m][n] * rs * g[1][n];
                        const f32x4 o1 = y1 * cs - y2 * sn, o2 = y2 * cs + y1 * sn;
                        w1[2 * n] = cvt_pk_bf16(o1[0], o1[1]); w1[2 * n + 1] = cvt_pk_bf16(o1[2], o1[3]);
                        w2[2 * n] = cvt_pk_bf16(o2[0], o2[1]); w2[2 * n + 1] = cvt_pk_bf16(o2[2], o2[3]);
                    }
                    bf16* p = base + (size_t)row * 1024 + vec * 64 + 8 * fq;
                    *(v4u*)p = w1; *(v4u*)(p + 32) = w2;
                }
        } else {
            const int col0 = (u.pn - 8) * 256 + wc * 32 + 8 * fq;
#pragma unroll
            for (int ai = 0; ai < 2; ++ai)
#pragma unroll
                for (int m = 0; m < 4; ++m) { bf16* rowp = V + (size_t)(row0 + ai * 128 + m * 16) * 1024 + col0;
#pragma unroll
                    for (int bj = 0; bj < 2; ++bj) { const f32x4 v0 = acc[ai][bj][m][0] * SC, v1 = acc[ai][bj][m][1] * SC; v4u w;
                        w.x = cvt_pk_bf16(v0[0], v0[1]); w.y = cvt_pk_bf16(v0[2], v0[3]); w.z = cvt_pk_bf16(v1[0], v1[1]); w.w = cvt_pk_bf16(v1[2], v1[3]);
                        *(v4u*)(rowp + bj * 128) = w; } }
        }
    }
};
struct EpiResid {
    const float* xin; const bf16* xinb; bf16* xout; const float* gvec; float* ssq;
    __device__ __forceinline__ void prefetch(pg8::EpiPre& p, const pg8::Unit& u, int wr, int wc, int fr, int fq) const {
        const int b = u.pm >> 4, col0 = u.pn * 256 + wc * 32 + 8 * fq;
#pragma unroll
        for (int bj = 0; bj < 2; ++bj)
#pragma unroll
            for (int n = 0; n < 2; ++n) p.v[2 * bj + n] = *(const f32x4*)(gvec + (size_t)b * 6144 + col0 + bj * 128 + 4 * n);
    }
    __device__ __forceinline__ void operator()(const f32x4 (&acc)[2][2][4][2], const pg8::Unit& u, int wr, int wc, int fr, int fq, const pg8::EpiPre& pre) const {
        const int row0 = u.pm * 256 + wr * 64 + fr, col0 = u.pn * 256 + wc * 32 + 8 * fq;
        f32x4 g[2][2];
#pragma unroll
        for (int bj = 0; bj < 2; ++bj)
#pragma unroll
            for (int n = 0; n < 2; ++n) g[bj][n] = pre.v[2 * bj + n];
        f32x4 cf[4], nf[4]; v4u cb[2], nb[2];
#define ER_LD(G_, XF, XB) do { const size_t off_ = (size_t)(row0 + ((G_) >> 2) * 128 + ((G_) & 3) * 16) * 1024 + col0; \
            if (xinb) { _Pragma("unroll") for (int q_ = 0; q_ < 2; ++q_) XB[q_] = *(const v4u*)(xinb + off_ + q_ * 128); } \
            else { _Pragma("unroll") for (int q_ = 0; q_ < 4; ++q_) XF[q_] = __builtin_nontemporal_load((const f32x4*)(xin + off_ + (q_ >> 1) * 128 + 4 * (q_ & 1))); } } while (0)
        ER_LD(0, cf, cb);
#pragma unroll
        for (int gi = 0; gi < 8; ++gi) { const int ai = gi >> 2, m = gi & 3;
            if (gi + 1 < 8) ER_LD(gi + 1, nf, nb);
            const size_t off = (size_t)(row0 + ai * 128 + m * 16) * 1024 + col0; float ss = 0.f;
#pragma unroll
            for (int bj = 0; bj < 2; ++bj) { v4u w;
#pragma unroll
                for (int n = 0; n < 2; ++n) { f32x4 xi; if (xinb) { const unsigned x0_ = n ? cb[bj].z : cb[bj].x, x1_ = n ? cb[bj].w : cb[bj].y; xi = (f32x4){bf_lo(x0_), bf_hi(x0_), bf_lo(x1_), bf_hi(x1_)}; } else xi = cf[2 * bj + n];
                    const f32x4 xo = xi + g[bj][n] * acc[ai][bj][m][n];
                    w[2 * n] = cvt_pk_bf16(xo[0], xo[1]); w[2 * n + 1] = cvt_pk_bf16(xo[2], xo[3]);
                    const float r0 = bf_lo(w[2 * n]), r1 = bf_hi(w[2 * n]), r2 = bf_lo(w[2 * n + 1]), r3 = bf_hi(w[2 * n + 1]);
                    ss += (r0 * r0 + r1 * r1) + (r2 * r2 + r3 * r3); }
                *(v4u*)(xout + off + bj * 128) = w; }
            ss = sum_fq4(ss);
            if (fq == 0) ssq[(size_t)(row0 + ai * 128 + m * 16) * 16 + u.pn * 4 + wc] = ss;
            if (gi + 1 < 8) {
#pragma unroll
                for (int q_ = 0; q_ < 4; ++q_) { cf[q_] = nf[q_]; cb[q_ >> 1] = nb[q_ >> 1]; } } }
#undef ER_LD
    }
};
__device__ __forceinline__ float softcap15(float z) { const float x = z * (1.0f / 15.0f); const float e = __expf(2.0f * x); return 15.0f * (1.0f - 2.0f / (e + 1.0f)); }
template <bool F8M> struct EpiMlIn {
    bf16 *MQ, *MK, *MV, *MO; float *IG, *LF; const float *bi, *bf_;
    __device__ __forceinline__ void prefetch(pg8::EpiPre&, const pg8::Unit&, int, int, int, int) const {}
    __device__ __forceinline__ void operator()(const f32x4 (&acc)[2][2][4][2], const pg8::Unit& u, int wr, int wc, int fr, int fq, const pg8::EpiPre&) const {
        const int row0 = u.pm * 256 + wr * 64 + fr;
        if (u.pn < 12) {
            constexpr float S0 = F8M ? WSCALE_INV : 1.0f;
            bf16* base; int ld, colt; float sc = S0; const bool sg = u.pn >= 8;
            if (u.pn < 2) { base = MQ; ld = 512; colt = u.pn * 256; }
            else if (u.pn < 4) { base = MK; ld = 512; colt = (u.pn - 2) * 256; sc = 0.125f * S0; }
            else if (u.pn < 8) { base = MV; ld = 1024; colt = (u.pn - 4) * 256; }
            else { base = MO; ld = 1024; colt = (u.pn - 8) * 256; }
            const int col0 = colt + wc * 32 + 8 * fq;
#pragma unroll
            for (int ai = 0; ai < 2; ++ai)
#pragma unroll
                for (int m = 0; m < 4; ++m) { bf16* rowp = base + (size_t)(row0 + ai * 128 + m * 16) * ld + col0;
#pragma unroll
                    for (int bj = 0; bj < 2; ++bj) { f32x4 v0 = acc[ai][bj][m][0] * sc, v1 = acc[ai][bj][m][1] * sc;
                        if (sg) {
#pragma unroll
                            for (int j = 0; j < 4; ++j) { v0[j] = sigmoidf_(v0[j]); v1[j] = sigmoidf_(v1[j]); } }
                        v4u w; w.x = cvt_pk_bf16(v0[0], v0[1]); w.y = cvt_pk_bf16(v0[2], v0[3]); w.z = cvt_pk_bf16(v1[0], v1[1]); w.w = cvt_pk_bf16(v1[2], v1[3]);
                        *(v4u*)(rowp + bj * 128) = w; } }
        } else if (wc == 0 && fq < 2) {
            const float* bb = fq == 0 ? bi : bf_; float* dst = fq == 0 ? IG : LF;
            const f32x4 b0 = *(const f32x4*)bb, b1 = *(const f32x4*)(bb + 4);
#pragma unroll
            for (int ai = 0; ai < 2; ++ai)
#pragma unroll
                for (int m = 0; m < 4; ++m) { const size_t row = (size_t)(row0 + ai * 128 + m * 16);
                    f32x4 v0 = acc[ai][0][m][0] + b0, v1 = acc[ai][0][m][1] + b1;
#pragma unroll
                    for (int j = 0; j < 4; ++j) { float z0 = softcap15(v0[j]), z1 = softcap15(v1[j]);
                        if (fq == 1) { z0 = fminf(z0, 0.f) - log1pf(__expf(-fabsf(z0))); z1 = fminf(z1, 0.f) - log1pf(__expf(-fabsf(z1))); }
                        v0[j] = z0; v1[j] = z1; }
                    *(f32x4*)(dst + row * 8) = v0; *(f32x4*)(dst + row * 8 + 4) = v1; }
        }
    }
};
struct EpiSwiglu {
    unsigned char* ACT; const float* bias;
    __device__ __forceinline__ void prefetch(pg8::EpiPre&, const pg8::Unit&, int, int, int, int) const {}
    __device__ __forceinline__ void operator()(const f32x4 (&acc)[2][2][4][2], const pg8::Unit& u, int wr, int wc, int fr, int fq, const pg8::EpiPre&) const {
        const int row0 = u.pm * 256 + wr * 64 + fr, cc = wc * 32 + 8 * fq;
        const float* bp = bias + (size_t)u.e * 2048 + u.pn * 256 + cc;
        f32x4 bg[2], bl[2];
#pragma unroll
        for (int n = 0; n < 2; ++n) { bg[n] = *(const f32x4*)(bp + 4 * n); bl[n] = *(const f32x4*)(bp + 128 + 4 * n) + 1.0f; }
        const int odd = fq & 1, ccw = wc * 32 + 8 * (fq & ~1);
#pragma unroll
        for (int ai = 0; ai < 2; ++ai)
#pragma unroll
            for (int mp = 0; mp < 2; ++mp) { v2u w[2];
#pragma unroll
                for (int q = 0; q < 2; ++q) { const int m = 2 * mp + q; float a[8];
#pragma unroll
                    for (int n = 0; n < 2; ++n) { const f32x4 gl = acc[ai][0][m][n] * WSCALE_INV + bg[n], li = acc[ai][1][m][n] * WSCALE_INV + bl[n];
#pragma unroll
                        for (int j = 0; j < 4; ++j) { const float gg = fminf(gl[j], 7.0f), l1 = fminf(fmaxf(li[j], -6.0f), 8.0f); a[4 * n + j] = gg * __builtin_amdgcn_rcpf(1.0f + __builtin_amdgcn_exp2f((-1.702f * 1.4426950408889634f) * gg)) * l1; } }
                    w[q] = pack8_fp8(a); }
                const auto sx = __builtin_amdgcn_permlane16_swap(w[0].x, w[1].x, false, false), sy = __builtin_amdgcn_permlane16_swap(w[0].y, w[1].y, false, false);
                v4u o; o.x = sx[0]; o.y = sy[0]; o.z = sx[1]; o.w = sy[1];
                *(v4u*)(ACT + (size_t)(row0 + ai * 128 + (2 * mp + odd) * 16) * 1024 + u.pn * 128 + ccw) = o; }
    }
};
struct EpiDown {
    unsigned char* Y; const float* bias;
    __device__ __forceinline__ void prefetch(pg8::EpiPre& p, const pg8::Unit& u, int wr, int wc, int fr, int fq) const {
        const float* bp = bias + (size_t)u.e * 1024 + u.pn * 256 + wc * 32 + 8 * fq;
#pragma unroll
        for (int bj = 0; bj < 2; ++bj)
#pragma unroll
            for (int n = 0; n < 2; ++n) p.v[2 * bj + n] = *(const f32x4*)(bp + bj * 128 + 4 * n);
    }
    __device__ __forceinline__ void operator()(const f32x4 (&acc)[2][2][4][2], const pg8::Unit& u, int wr, int wc, int fr, int fq, const pg8::EpiPre& pre) const {
        const int row0 = u.pm * 256 + wr * 64 + fr, col0 = u.pn * 256 + wc * 32 + 8 * fq;
        const int odd = fq & 1, colw = u.pn * 256 + wc * 32 + 8 * (fq & ~1);
#pragma unroll
        for (int ai = 0; ai < 2; ++ai)
#pragma unroll
            for (int mp = 0; mp < 2; ++mp) { unsigned char* rowp = Y + (size_t)(row0 + ai * 128 + (2 * mp + odd) * 16) * 1024 + colw;
#pragma unroll
                for (int bj = 0; bj < 2; ++bj) { v2u w[2];
#pragma unroll
                    for (int q = 0; q < 2; ++q) { const int m = 2 * mp + q; const f32x4 v0 = acc[ai][bj][m][0] * WSCALE_INV + pre.v[2 * bj], v1 = acc[ai][bj][m][1] * WSCALE_INV + pre.v[2 * bj + 1];
                        const float y8[8] = {v0[0], v0[1], v0[2], v0[3], v1[0], v1[1], v1[2], v1[3]}; w[q] = pack8_fp8(y8); }
                    const auto sx = __builtin_amdgcn_permlane16_swap(w[0].x, w[1].x, false, false), sy = __builtin_amdgcn_permlane16_swap(w[0].y, w[1].y, false, false);
                    v4u o; o.x = sx[0]; o.y = sy[0]; o.z = sx[1]; o.w = sy[1];
                    *(v4u*)(rowp + bj * 128) = o; } }
    }
};

struct EpiMoe {
    int kind; EpiSwiglu a; EpiDown b;
    __device__ __forceinline__ void prefetch(pg8::EpiPre&, const pg8::Unit&, int, int, int, int) const {}
    __device__ __forceinline__ void operator()(const f32x4 (&acc)[2][2][4][2], const pg8::Unit& u, int wr, int wc, int fr, int fq, const pg8::EpiPre&) const {
        if (kind == 0) { pg8::EpiPre d; a(acc, u, wr, wc, fr, fq, d); }
        else { pg8::EpiPre p; b.prefetch(p, u, wr, wc, fr, fq); b(acc, u, wr, wc, fr, fq, p); }
    }
};
template <bool GATHER_> struct MoeSched {
    static constexpr bool GATHER = GATHER_;
    const LAS int* cnt; const LAS int* tstart; const LAS int* tile_e; const int* list; int NN, NB_, G, c;
    int rtgather = 1;
    __device__ __forceinline__ bool next(int i, pg8::Unit& u) const {
        const int MT = __builtin_amdgcn_readfirstlane(tstart[32]);
        int L = i * G + c;
        if (G % (8 * NN) == 0) { const int x = c & 7, j = c >> 3, mpx = G / (8 * NN); L = i * G + (x * mpx + j / NN) * NN + j % NN; }
        if (L >= MT * NN) return false;
        u.pm = L / NN; u.pn = L % NN; u.e = __builtin_amdgcn_readfirstlane(tile_e[u.pm]); return true;
    }
    __device__ __forceinline__ unsigned a_row(const pg8::Unit& u, int r) const {
        if (!GATHER_ || !rtgather) return (unsigned)(u.pm * 256 + r);
        int pos = (u.pm - tstart[u.e]) * 256 + r; const int n = cnt[u.e]; pos = pos < n ? pos : n - 1;
        return (unsigned)(list[u.e * T + pos] >> 2);
    }
    __device__ __forceinline__ unsigned b_row0(const pg8::Unit& u) const { return (unsigned)(u.e * NB_ + u.pn * 256); }
};

struct Ctx { LAS unsigned char* lds; int tid, lane, wave, G, bid; };

template <class RowMap>
__device__ __forceinline__ void transpose_item(const float* W, int N, bf16* WT, LAS float* scr, int item, int lane, const RowMap& rm) {
    const int nblk = (N + 31) / 32, kb = item / nblk, nb = item % nblk, k0 = 64 * kb, n0 = 32 * nb;
    const int nc = n0 + (lane & 31); const bool ok = nc < N;
#pragma unroll 16
    for (int i = 0; i < 32; ++i) { const int kk = 2 * i + (lane >> 5); scr[kk * 33 + (lane & 31)] = ok ? W[(size_t)(k0 + kk) * N + nc] : 0.f; }
    LDS_WAIT(); asm volatile("" ::: "memory");
    const int c = lane & 7;
#pragma unroll
    for (int j = 0; j < 4; ++j) { const int n = (lane >> 3) + 8 * j; const LAS float* s = scr + (8 * c) * 33 + n;
        v4u o; o.x = cvt_pk_bf16(s[0 * 33], s[1 * 33]); o.y = cvt_pk_bf16(s[2 * 33], s[3 * 33]); o.z = cvt_pk_bf16(s[4 * 33], s[5 * 33]); o.w = cvt_pk_bf16(s[6 * 33], s[7 * 33]);
        *(GAS v4u*)(WT + (size_t)rm(n0 + n) * 1024 + k0 + 8 * c) = o; }
    LDS_WAIT(); asm volatile("" ::: "memory");
}
template <class RowMap>
__device__ __forceinline__ void transpose_item_f8(const float* W, int N, unsigned char* WT, LAS float* scr, int item, int lane, const RowMap& rm) {
    const int nblk = N / 32, kb = item / nblk, nb = item % nblk, k0 = 64 * kb, n0 = 32 * nb;
#pragma unroll 16
    for (int i = 0; i < 32; ++i) { const int kk = 2 * i + (lane >> 5); scr[kk * 33 + (lane & 31)] = W[(size_t)(k0 + kk) * N + n0 + (lane & 31)]; }
    LDS_WAIT(); asm volatile("" ::: "memory");
    const int c = lane & 7;
#pragma unroll
    for (int j = 0; j < 4; ++j) { const int n = (lane >> 3) + 8 * j; const LAS float* sp = scr + (8 * c) * 33 + n; float x[8];
#pragma unroll
        for (int q = 0; q < 8; ++q) x[q] = sp[q * 33] * WSCALE;
        *(GAS v2u*)(WT + (size_t)rm(n0 + n) * 1024 + k0 + 8 * c) = pack8_fp8(x); }
    LDS_WAIT(); asm volatile("" ::: "memory");
}
struct CvtItem { const float* W; unsigned char* WT; int N, isgu, rowoff, k0, n0; };
__device__ __forceinline__ CvtItem cvt_decode(int it, const float* WGUf, const float* WDNf, unsigned char* Wgu8, unsigned char* Wdn8) {
    constexpr int IGU = 16 * 64, IDN = 16 * 32; CvtItem c;
    if (it < 64 * IGU) { const int le = it / IGU, r = it % IGU; c.W = WGUf + (size_t)le * 1024 * 2048; c.WT = Wgu8; c.N = 2048; c.isgu = 1; c.rowoff = le * 2048; c.k0 = 64 * (r / 64); c.n0 = 32 * (r % 64); }
    else { const int q = it - 64 * IGU, le = q / IDN, r = q % IDN; c.W = WDNf + (size_t)le * 1024 * 1024; c.WT = Wdn8; c.N = 1024; c.isgu = 0; c.rowoff = le * 1024; c.k0 = 64 * (r / 32); c.n0 = 32 * (r % 32); }
    return c;
}
__device__ __forceinline__ void cvt_load(const CvtItem& c, int lane, float (&r)[32]) {
    const float* p = c.W + (size_t)(c.k0 + (lane >> 5)) * c.N + c.n0 + (lane & 31);
#pragma unroll
    for (int i = 0; i < 32; ++i) r[i] = __builtin_nontemporal_load(p + (size_t)(2 * i) * c.N);
}
__device__ __forceinline__ void cvt_finish(const CvtItem& c, int lane, const float (&r)[32], LAS float* scr) {
#pragma unroll
    for (int i = 0; i < 32; ++i) scr[(2 * i + (lane >> 5)) * 33 + (lane & 31)] = r[i];
    LDS_WAIT(); asm volatile("" ::: "memory");
    const int cc = lane & 7;
#pragma unroll
    for (int j = 0; j < 4; ++j) { const int n = (lane >> 3) + 8 * j; const LAS float* sp = scr + (8 * cc) * 33 + n; float x[8];
#pragma unroll
        for (int q = 0; q < 8; ++q) x[q] = sp[q * 33] * WSCALE;
        const int L = c.n0 + n; int prow;
        if (c.isgu) { const int jj_ = L >> 1, bj = L & 1; prow = c.rowoff + 256 * (jj_ >> 7) + 128 * bj + (jj_ & 127); } else prow = c.rowoff + L;
        *(GAS v2u*)(c.WT + (size_t)prow * 1024 + c.k0 + 8 * cc) = pack8_fp8(x); }
    LDS_WAIT(); asm volatile("" ::: "memory");
}
struct RmId { int off; __device__ __forceinline__ int operator()(int n) const { return off + n; } };
struct RmQK { __device__ __forceinline__ int operator()(int n) const { if (n >= 2048) return n; const int b = n >> 5, pn = b >> 3, wc = (b >> 1) & 3, bj = b & 1; return (pn * 8 + bj * 4 + wc) * 32 + (n & 31); } };
struct RmGU { int off; __device__ __forceinline__ int operator()(int n) const { const int j = n >> 1, bj = n & 1, pn = j >> 7, jj = j & 127; return off + 256 * pn + 128 * bj + jj; } };

__device__ __forceinline__ void norm_row_store_f8(const f32x4 (&v)[4], const float* gain, const float* sc, const float* sh, unsigned char* orow, int lane) {
    float ss = 0.f;
#pragma unroll
    for (int j = 0; j < 4; ++j) ss += (v[j][0] * v[j][0] + v[j][1] * v[j][1]) + (v[j][2] * v[j][2] + v[j][3] * v[j][3]);
    const float rs = rsqrtf(wave_sum(ss) * (1.0f / 1024.0f) + RMS_EPS);
#pragma unroll
    for (int j = 0; j < 4; ++j) { const int c = 4 * lane + 256 * j;
        const f32x4 g = *(const f32x4*)(gain + c), s = *(const f32x4*)(sc + c), h = *(const f32x4*)(sh + c);
        const f32x4 o = v[j] * rs * g * (s + 1.0f) + h;
        int w = 0; w = __builtin_amdgcn_cvt_pk_fp8_f32(o[0], o[1], w, false); w = __builtin_amdgcn_cvt_pk_fp8_f32(o[2], o[3], w, true);
        *(int*)(orow + c) = w; }
}
__device__ __forceinline__ void norm_row_store(const f32x4 (&v)[4], const float* gain, const float* sc, const float* sh, bf16* orow, int lane) {
    float ss = 0.f;
#pragma unroll
    for (int j = 0; j < 4; ++j) ss += (v[j][0] * v[j][0] + v[j][1] * v[j][1]) + (v[j][2] * v[j][2] + v[j][3] * v[j][3]);
    const float rs = rsqrtf(wave_sum(ss) * (1.0f / 1024.0f) + RMS_EPS);
#pragma unroll
    for (int j = 0; j < 4; ++j) { const int c = 4 * lane + 256 * j;
        const f32x4 g = *(const f32x4*)(gain + c), s = *(const f32x4*)(sc + c), h = *(const f32x4*)(sh + c);
        const f32x4 o = v[j] * rs * g * (s + 1.0f) + h;
        v2u w; w.x = cvt_pk_bf16(o[0], o[1]); w.y = cvt_pk_bf16(o[2], o[3]);
        *(v2u*)(orow + c) = w; }
}


#define ML_BAR() asm volatile("s_waitcnt lgkmcnt(0)\n\ts_barrier" ::: "memory")
template <bool FULL>
__device__ __forceinline__ void mlstm_stream(LAS unsigned char* ldsp, unsigned char* ws, const float* ogain, int b, int h, int cbeg, int nch, int tid, int lane, int wave,
                                             f32x16& CT, float& gsum, float& nreg) {
    const bf16 *MQ_ = (const bf16*)(ws + WS_MQ), *MK_ = (const bf16*)(ws + WS_MK), *MV_ = (const bf16*)(ws + WS_MV), *MO_ = (const bf16*)(ws + WS_MO);
    const float *IG_ = (const float*)(ws + WS_IG), *LF_ = (const float*)(ws + WS_LF); bf16* ATTC_ = (bf16*)(ws + WS_ATTC);
    constexpr int QS = 72, A2S = 136, HS = 132;
    LAS bf16* Qn = (LAS bf16*)ldsp;
    LAS bf16* Kn = Qn + 64 * QS;
    LAS bf16* Kwt = Kn + 64 * QS;
    LAS bf16* A2 = Kwt + 64 * QS;
    LAS bf16* B2t = A2 + 64 * A2S;
    LAS float* Hout = (LAS float*)(B2t + 128 * A2S);
    LAS float* vec = Hout + 64 * HS;
    LAS float *v_u = vec, *v_w = vec + 64, *v_eb = vec + 128, *v_dp0 = vec + 192, *v_dp1 = vec + 256, *v_di = vec + 320, *v_n = vec + 384;
    const int r32 = lane & 31, hi = lane >> 5, row = 8 * wave + (lane >> 3), ch = lane & 7, tsw = ((wave ^ ch) << 3) + (lane >> 3);
    const int hrow = wave * 8 + (lane >> 3), hpart = lane & 7;
    LAS float* v_gn = vec + 448;
    if (FULL) {
#pragma unroll
        for (int j = 0; j < 4; ++j) *(LAS f32x4*)(v_gn + 16 * hpart + 4 * j) = *(const f32x4*)(ogain + h * 128 + 16 * hpart + 4 * j);
        const int vb = wave >> 1, db = wave & 1;
#pragma unroll
        for (int r = 0; r < 16; ++r) { const int v = 32 * vb + (r & 3) + 8 * (r >> 2) + 4 * hi; B2t[v * A2S + 64 + 32 * db + r32] = (bf16)(cvt_pk_bf16(CT[r], 0.f) & 0xffffu); }
        if (wave == 3) v_n[lane] = nreg; }
    v4u pq = {0u, 0u, 0u, 0u}, pk, pv0, pv1, pog0 = {0u, 0u, 0u, 0u}, pog1 = {0u, 0u, 0u, 0u}; float pig, plf;
#define ML_LOAD(cc) do { const size_t t0_ = (size_t)b * SEQ + (size_t)(cc) * 64; \
        if (FULL) pq = *(const v4u*)(MQ_ + (t0_ + row) * 512 + h * 64 + 8 * ch); \
        pk = *(const v4u*)(MK_ + (t0_ + row) * 512 + h * 64 + 8 * ch); \
        pv0 = *(const v4u*)(MV_ + (t0_ + row) * 1024 + h * 128 + 8 * ch); pv1 = *(const v4u*)(MV_ + (t0_ + row) * 1024 + h * 128 + 8 * (ch + 8)); \
        pig = IG_[(t0_ + lane) * 8 + h]; plf = LF_[(t0_ + lane) * 8 + h]; \
        if (FULL) { pog0 = *(const v4u*)(MO_ + (t0_ + hrow) * 1024 + h * 128 + 16 * hpart); pog1 = *(const v4u*)(MO_ + (t0_ + hrow) * 1024 + h * 128 + 16 * hpart + 8); } } while (0)
    ML_LOAD(cbeg);
    ML_BAR();
    for (int c = cbeg; c < cbeg + nch; ++c) {
        const size_t t0 = (size_t)b * SEQ + (size_t)c * 64;
        float bcs = plf;
        bcs += dppf<0x111, 0xf>(bcs); bcs += dppf<0x112, 0xf>(bcs); bcs += dppf<0x114, 0xf>(bcs); bcs += dppf<0x118, 0xf>(bcs);
        bcs += dppf<0x142, 0xa>(bcs); bcs += dppf<0x143, 0xc>(bcs);
        const float g = __int_as_float(__builtin_amdgcn_readlane(__float_as_int(bcs), 63)), ig = pig, eb = __expf(bcs), wk = __expf(g - bcs + ig), eg = __expf(g);
        gsum += g;
        const float wk_r = __shfl(wk, row), eb_r = __shfl(eb, row);
        v4u ogc0 = pog0, ogc1 = pog1;
        if (FULL) {
            v_u[lane] = bcs * 1.4426950408889634f; v_w[lane] = (bcs - ig) * 1.4426950408889634f; v_eb[lane] = eb; v_dp1[lane] = 0.f;
            *(LAS v4u*)(Qn + row * QS + 8 * ch) = pq; *(LAS v4u*)(Kn + row * QS + 8 * ch) = pk;
            v4u o;
#pragma unroll
            for (int j = 0; j < 4; ++j) o[j] = cvt_pk_bf16(bf_lo(pq[j]) * eb_r, bf_hi(pq[j]) * eb_r);
            *(LAS v4u*)(A2 + row * A2S + 64 + 8 * ch) = o;
        }
#pragma unroll
        for (int j = 0; j < 4; ++j) { const unsigned a = cvt_pk_bf16(bf_lo(pk[j]) * wk_r, bf_hi(pk[j]) * wk_r);
            Kwt[(8 * ch + 2 * j) * QS + tsw] = (bf16)(a & 0xffffu); Kwt[(8 * ch + 2 * j + 1) * QS + tsw] = (bf16)(a >> 16);
            B2t[(8 * ch + 2 * j) * A2S + tsw] = (bf16)(pv0[j] & 0xffffu); B2t[(8 * ch + 2 * j + 1) * A2S + tsw] = (bf16)(pv0[j] >> 16);
            B2t[(8 * (ch + 8) + 2 * j) * A2S + tsw] = (bf16)(pv1[j] & 0xffffu); B2t[(8 * (ch + 8) + 2 * j + 1) * A2S + tsw] = (bf16)(pv1[j] >> 16); }
        if (c + 1 < cbeg + nch) ML_LOAD(c + 1);
        ML_BAR();
        if (FULL) {
            if (wave < 3) {
                const int sb = wave == 2 ? 1 : 0, lb = wave == 0 ? 0 : 1;
                f32x16 p;
#pragma unroll
                for (int r = 0; r < 16; ++r) p[r] = 0.f;
#pragma unroll
                for (int kk = 0; kk < 4; ++kk) { const bf16x8 af = *(const LAS bf16x8*)(Kn + (32 * sb + r32) * QS + 16 * kk + 8 * hi), bfr = *(const LAS bf16x8*)(Qn + (32 * lb + r32) * QS + 16 * kk + 8 * hi);
                    p = __builtin_amdgcn_mfma_f32_32x32x16_bf16(af, bfr, p, 0, 0, 0); }
                const int l = 32 * lb + r32; const float ul = v_u[l]; float dsum = 0.f;
#pragma unroll
                for (int r = 0; r < 16; ++r) { const int s_ = 32 * sb + (r & 3) + 8 * (r >> 2) + 4 * hi; const float dd = (s_ <= l) ? __builtin_amdgcn_exp2f(ul - v_w[s_]) : 0.f; p[r] *= dd; dsum += p[r]; }
                { const unsigned u_ = __float_as_uint(dsum); auto r_ = __builtin_amdgcn_permlane32_swap(u_, u_, false, false); dsum = __uint_as_float(r_[0]) + __uint_as_float(r_[1]); }
                if (hi == 0) { if (sb == 0) v_dp0[l] = dsum; else v_dp1[l] = dsum; }
#pragma unroll
                for (int g4 = 0; g4 < 4; ++g4) { v2u w; w.x = cvt_pk_bf16(p[4 * g4], p[4 * g4 + 1]); w.y = cvt_pk_bf16(p[4 * g4 + 2], p[4 * g4 + 3]);
                    *(LAS v2u*)(A2 + l * A2S + 32 * sb + 8 * g4 + 4 * hi) = w; }
            } else if (wave == 3) {
                for (int i = lane; i < 32 * 16; i += 64) { const int l = i >> 4, c2 = i & 15; *(LAS unsigned*)(A2 + l * A2S + 32 + 2 * c2) = 0u; }
            } else if (wave == 4) {
                float s0 = 0.f, s1 = 0.f, s2 = 0.f, s3 = 0.f;
#pragma unroll 2
                for (int d8 = 0; d8 < 8; ++d8) { const v4u qv = *(const LAS v4u*)(Qn + lane * QS + 8 * d8); const f32x4 n0 = *(const LAS f32x4*)(v_n + 8 * d8), n1 = *(const LAS f32x4*)(v_n + 8 * d8 + 4);
                    s0 += bf_lo(qv.x) * n0[0]; s1 += bf_hi(qv.x) * n0[1]; s2 += bf_lo(qv.y) * n0[2]; s3 += bf_hi(qv.y) * n0[3];
                    s0 += bf_lo(qv.z) * n1[0]; s1 += bf_hi(qv.z) * n1[1]; s2 += bf_lo(qv.w) * n1[2]; s3 += bf_hi(qv.w) * n1[3]; }
                v_di[lane] = ((s0 + s1) + (s2 + s3)) * eb;
            }
            ML_BAR();
            {
                const int lb = wave >> 2, vb = wave & 3;
                f32x16 nm;
#pragma unroll
                for (int r = 0; r < 16; ++r) nm[r] = 0.f;
#pragma unroll
                for (int kk = 0; kk < 8; ++kk) { const bf16x8 af = *(const LAS bf16x8*)(A2 + (32 * lb + r32) * A2S + 16 * kk + 8 * hi), bfr = *(const LAS bf16x8*)(B2t + (32 * vb + r32) * A2S + (kk < 4 ? (((2 * kk + hi) ^ ((4 * vb + (r32 >> 3)) & 7)) << 3) : 16 * kk + 8 * hi));
                    nm = __builtin_amdgcn_mfma_f32_32x32x16_bf16(af, bfr, nm, 0, 0, 0); }
#pragma unroll
                for (int r = 0; r < 16; ++r) { const int l = 32 * lb + (r & 3) + 8 * (r >> 2) + 4 * hi; const float den = v_dp0[l] + v_dp1[l] + v_di[l];
                    Hout[l * HS + 32 * vb + r32] = nm[r] * __builtin_amdgcn_rcpf(fmaxf(fabsf(den), 1.0f)); }
            }
        }
        {
            const int vb = wave >> 1, db = wave & 1;
#pragma unroll
            for (int r = 0; r < 16; ++r) CT[r] *= eg;
#pragma unroll
            for (int kk = 0; kk < 4; ++kk) { const bf16x8 af = *(const LAS bf16x8*)(B2t + (32 * vb + r32) * A2S + (((2 * kk + hi) ^ ((4 * vb + (r32 >> 3)) & 7)) << 3)), bfr = *(const LAS bf16x8*)(Kwt + (32 * db + r32) * QS + (((2 * kk + hi) ^ ((4 * db + (r32 >> 3)) & 7)) << 3));
                CT = __builtin_amdgcn_mfma_f32_32x32x16_bf16(af, bfr, CT, 0, 0, 0); }
            if (wave == 3) { float s0 = 0.f, s1 = 0.f, s2 = 0.f, s3 = 0.f;
#pragma unroll 2
                for (int l8 = 0; l8 < 8; ++l8) { const v4u kv = *(const LAS v4u*)(Kwt + lane * QS + 8 * l8);
                    s0 += bf_lo(kv.x) + bf_hi(kv.x); s1 += bf_lo(kv.y) + bf_hi(kv.y); s2 += bf_lo(kv.z) + bf_hi(kv.z); s3 += bf_lo(kv.w) + bf_hi(kv.w); }
                nreg = eg * nreg + ((s0 + s1) + (s2 + s3)); }
        }
        ML_BAR();
        if (FULL) {
            const int vb = wave >> 1, db = wave & 1;
#pragma unroll
            for (int r = 0; r < 16; ++r) { const int v = 32 * vb + (r & 3) + 8 * (r >> 2) + 4 * hi; B2t[v * A2S + 64 + 32 * db + r32] = (bf16)(cvt_pk_bf16(CT[r], 0.f) & 0xffffu); }
            if (wave == 3) v_n[lane] = nreg;
            {
                f32x4 hv[4]; float ss = 0.f;
#pragma unroll
                for (int j = 0; j < 4; ++j) { hv[j] = *(const LAS f32x4*)(Hout + hrow * HS + 16 * hpart + 4 * j); ss += (hv[j][0] * hv[j][0] + hv[j][1] * hv[j][1]) + (hv[j][2] * hv[j][2] + hv[j][3] * hv[j][3]); }
                ss = sum_lanes8(ss);
                const float rs = rsqrtf(ss * (1.0f / 128.0f) + RMS_EPS);
                v4u w0, w1;
#pragma unroll
                for (int j = 0; j < 2; ++j) { const f32x4 y = hv[j] * rs * *(const LAS f32x4*)(v_gn + 16 * hpart + 4 * j); w0[2 * j] = cvt_pk_bf16(y[0] * bf_lo(ogc0[2 * j]), y[1] * bf_hi(ogc0[2 * j])); w0[2 * j + 1] = cvt_pk_bf16(y[2] * bf_lo(ogc0[2 * j + 1]), y[3] * bf_hi(ogc0[2 * j + 1])); }
#pragma unroll
                for (int j = 0; j < 2; ++j) { const f32x4 y = hv[2 + j] * rs * *(const LAS f32x4*)(v_gn + 16 * hpart + 4 * (2 + j)); w1[2 * j] = cvt_pk_bf16(y[0] * bf_lo(ogc1[2 * j]), y[1] * bf_hi(ogc1[2 * j])); w1[2 * j + 1] = cvt_pk_bf16(y[2] * bf_lo(ogc1[2 * j + 1]), y[3] * bf_hi(ogc1[2 * j + 1])); }
                bf16* dst = ATTC_ + (t0 + hrow) * 1024 + h * 128 + 16 * hpart;
                *(v4u*)dst = w0; *(v4u*)(dst + 8) = w1;
            }
        }
    }
    ML_BAR();
#undef ML_LOAD
}

#ifndef PHMASK
#define PHMASK 0xffffffffu
#endif
#define PH(n) (((PHMASK) >> (n)) & 1u)
#ifndef REPMASK
#define REPMASK 0u
#endif
#define REPS(n) (1 + (int)(((REPMASK) >> (n)) & 1u))
__global__ void __launch_bounds__(512, 2) fwd(Params P) {
    extern __shared__ __attribute__((aligned(16))) unsigned char lds_raw[];
    LAS unsigned char* lds = (LAS unsigned char*)lds_raw;
    const int G = gridDim.x, bid = blockIdx.x, NGW = G * 8;
    for (int u = threadIdx.x; u < (LDS_BYTES - LDSCTL_OFF) / 4; u += 512) ((LAS unsigned*)(lds + LDSCTL_OFF))[u] = 0u;
    __syncthreads();
typedef const __attribute__((address_space(4))) Params* CParamsPtr;
#define BAR_OBJ(b_) XcdBarrier b_; { CParamsPtr pq_ = (CParamsPtr)__builtin_amdgcn_kernarg_segment_ptr(); asm volatile("" : "+s"(pq_)); b_.bar = (unsigned*)(pq_->ws + WS_CTL) + CW_BAR; b_.x = xb_xcc_id(); \
    b_.st = (volatile LAS unsigned*)(lds + LDSCTL_OFF + LT_MISC) + 8; }
    { BAR_OBJ(b0_); if (threadIdx.x == 0) (void)xb_add(&b0_.bar[XB_XCNT(b0_.x)], 1u); }
#define GRID_BAR() do { BAR_OBJ(bb_); xcd_barrier(bb_); } while (0)
#define PH_BEGIN CParamsPtr pp = (CParamsPtr)__builtin_amdgcn_kernarg_segment_ptr(); asm volatile("" : "+s"(pp)); unsigned char* const ws = pp->ws; \
    int tid_o = threadIdx.x; asm volatile("" : "+v"(tid_o)); const int tid = tid_o, lane = tid & 63, wave = __builtin_amdgcn_readfirstlane(tid >> 6), gw = bid * 8 + wave; (void)gw; (void)lane; (void)ws; \
    int ldso_ = 0; asm volatile("" : "+s"(ldso_)); LAS unsigned char* const ldsp = (LAS unsigned char*)(size_t)(unsigned)ldso_; (void)ldsp;
#define Lcnt ((LAS int*)(ldsp + LDSCTL_OFF + LT_CNT))
#define Ltstart ((LAS int*)(ldsp + LDSCTL_OFF + LT_TSTART))
#define Ltilee ((LAS int*)(ldsp + LDSCTL_OFF + LT_TILEE))
#define ctl ((unsigned*)(ws + WS_CTL))
#define modF ((float*)(ws + WS_MODF))
#define lamp ((float*)(ws + WS_LAM))
#define bgup ((float*)(ws + WS_BGUP))
#define rwt ((bf16*)(ws + WS_RWT))
#define rope ((float*)(ws + WS_ROPE))
#define Wqkv ((bf16*)(ws + WS_WQKV))
#define Wo ((bf16*)(ws + WS_WO))
#define Wml ((bf16*)(ws + WS_WML))
#define WGP ((bf16*)(ws + WS_ROPE + 4 * MiB))
#define CGP ((float*)(ws + WS_ROPE + 5 * MiB))
#define Wml8 ((unsigned char*)(ws + WS_WQKV + 3 * MiB))
#define Hb8L1 ((unsigned char*)(ws + WS_ATTC))
#define Wmlo ((bf16*)(ws + WS_WMLO))
#define toke ((int*)(ws + WS_TOKE))
#define gatew ((float*)(ws + WS_GATE))
#define list ((int*)(ws + WS_LIST))
#define IG ((float*)(ws + WS_IG))
#define LF ((float*)(ws + WS_LF))
#define Wgu ((bf16*)(ws + WS_WGU))
#define Wdn ((bf16*)(ws + WS_WDN))
#define Hb ((bf16*)(ws + WS_H))
#define Qb ((bf16*)(ws + WS_Q))
#define Kb ((bf16*)(ws + WS_K))
#define Vb ((bf16*)(ws + WS_V))
#define MQ ((bf16*)(ws + WS_MQ))
#define MK ((bf16*)(ws + WS_MK))
#define MV ((bf16*)(ws + WS_MV))
#define MO ((bf16*)(ws + WS_MO))
#define OB ((bf16*)(ws + WS_OB))
#define ATTC ((bf16*)(ws + WS_ATTC))
#define X1 ((bf16*)(ws + WS_X1))
#define X2 ((bf16*)(ws + WS_X2))
#define ACT ((bf16*)(ws + WS_ACT))
#define Yb ((bf16*)(ws + WS_Y))
#define mdL (modF + (size_t)layer * 8 * 6144)

    if (PH(0)) { PH_BEGIN
        if (bid < 192) {
            LAS float* cact = (LAS float*)lds; LAS float* red = cact + 8192;
            for (int i = tid; i < 8192; i += 512) { const float v = pp->in[I_C][i]; cact[i] = v / (1.0f + __expf(-v)); }
            __syncthreads();
            const int col0 = bid * 64, layer = col0 / 6144, cc = col0 % 6144;
            const float* W = pp->in[I_ADAW] + (size_t)layer * 1024 * 6144 + cc + lane;
            float a[8];
#pragma unroll
            for (int b = 0; b < 8; ++b) a[b] = 0.f;
#pragma unroll 8
            for (int k = wave * 128; k < wave * 128 + 128; ++k) { const float w = W[(size_t)k * 6144];
#pragma unroll
                for (int b = 0; b < 8; ++b) a[b] += cact[b * 1024 + k] * w; }
#pragma unroll
            for (int b = 0; b < 8; ++b) red[(wave * 8 + b) * 64 + lane] = a[b];
            __syncthreads();
            { const int b = tid >> 6, l = tid & 63; float s = pp->in[I_ADAB][layer * 6144 + cc + l];
#pragma unroll
              for (int w = 0; w < 8; ++w) s += red[(w * 8 + b) * 64 + l];
              modF[(size_t)(layer * 8 + b) * 6144 + cc + l] = s; }
            __syncthreads();
        }
        for (int idx = bid * 512 + tid; idx < T * 32; idx += G * 512) { const int t = idx >> 5, i = idx & 31;
            const float ang = (float)((const int*)pp->in[I_POS])[t] * pp->invf[i];
            const double x = (double)ang * 0.15915494309189535; const float fr_ = (float)(x - rint(x));
            ((bf16*)rope)[(size_t)t * 64 + i] = (bf16)(cvt_pk_bf16(__builtin_amdgcn_cosf(fr_), 0.f) & 0xffffu); ((bf16*)rope)[(size_t)t * 64 + 32 + i] = (bf16)(cvt_pk_bf16(__builtin_amdgcn_sinf(fr_), 0.f) & 0xffffu); }
        if (bid == G - 1 && wave == 0) {
            const float s1 = wave_sum(pp->in[I_LQ1][lane] * pp->in[I_LK1][lane]), s2 = wave_sum(pp->in[I_LQ2][lane] * pp->in[I_LK2][lane]);
            if (lane == 0) lamp[0] = expf(s1) - expf(s2) + 0.2f;
        }
        for (int idx = bid * 512 + tid; idx < 2 * 1024 * 32; idx += G * 512) { const int layer = idx >> 15, k = (idx >> 5) & 1023, e = idx & 31;
            const float w = pp->in[I_RW][idx]; const unsigned hi = cvt_pk_bf16(w, 0.f) & 0xffffu; const float lo = w - bf_lo(hi);
            rwt[(size_t)(layer * 32 + e) * 1024 + k] = (bf16)hi; rwt[(size_t)(64 + layer * 32 + e) * 1024 + k] = (bf16)(cvt_pk_bf16(lo, 0.f) & 0xffffu); }
        for (int idx = bid * 512 + tid; idx < 2 * 32 * 2048; idx += G * 512) { const int n = idx & 2047, le = idx >> 11; const RmGU rm{0}; bgup[(size_t)le * 2048 + rm(n)] = pp->in[I_BGU][idx]; }
        LAS float* scr = (LAS float*)(lds + wave * 16384);
        constexpr int I_A = 16 * 96, I_B = 16 * 32, I_C2 = 0, I_E = 16 * 96, I_D = 16 * 32;
        for (int it = gw; it < I_A + I_B + I_C2 + I_E + I_D; it += NGW) {
            int r = it;
            if (r < I_A) { transpose_item_f8(pp->in[I_AWIN], 3072, (unsigned char*)Wqkv, scr, r, lane, RmQK{}); continue; } r -= I_A;
            if (r < I_B) { transpose_item(pp->in[I_AWOUT], 1024, Wo, scr, r, lane, RmId{0}); continue; } r -= I_B;
            if (r < I_E) { transpose_item_f8(pp->in[I_MWIN], 3088, Wml8, scr, r, lane, RmId{0}); continue; } r -= I_E;
            transpose_item(pp->in[I_MWOUT], 1024, Wmlo, scr, r, lane, RmId{0});
        }
        {
            constexpr int NIT = 64 * (16 * 64 + 16 * 32), PFXN = 11;
            const float* WGUf = pp->in[I_WGU]; const float* WDNf = pp->in[I_WDN]; unsigned char* Wgu8 = (unsigned char*)Wgu; unsigned char* Wdn8 = (unsigned char*)Wdn;
            const int nmw = G > 192 ? (G - 192) * 8 : 0, gwn = (bid - 192) * 8 + wave, pfx = nmw * PFXN; const bool nonmod = bid >= 192;
#define CVT_SEQ(j) (nonmod ? ((j) < PFXN ? gwn + (j) * nmw : pfx + gw + ((j) - PFXN) * NGW) : pfx + gw + (j) * NGW)
            float ra[32], rb[32];
            int j = 0, it = CVT_SEQ(0);
            if (it < NIT) { const CvtItem c0 = cvt_decode(it, WGUf, WDNf, Wgu8, Wdn8); cvt_load(c0, lane, ra); }
            for (; it < NIT; j += 2, it = CVT_SEQ(j)) {
                const CvtItem ca = cvt_decode(it, WGUf, WDNf, Wgu8, Wdn8);
                const int itb = CVT_SEQ(j + 1), itc = CVT_SEQ(j + 2);
                const bool hb = itb < NIT, hc = itc < NIT;
                if (hb) { const CvtItem cb = cvt_decode(itb, WGUf, WDNf, Wgu8, Wdn8); cvt_load(cb, lane, rb); }
                cvt_finish(ca, lane, ra, scr);
                if (hc) { const CvtItem cc = cvt_decode(itc, WGUf, WDNf, Wgu8, Wdn8); cvt_load(cc, lane, ra); }
                if (hb) { const CvtItem cb = cvt_decode(itb, WGUf, WDNf, Wgu8, Wdn8); cvt_finish(cb, lane, rb, scr); }
            }
#undef CVT_SEQ
        }
    }
    GRID_BAR();

    for (int rep_ = 0; rep_ < REPS(1); ++rep_) {
    if (PH(1)) { PH_BEGIN
        {
            const float* Win = pp->in[I_MWIN];
            for (int idx = bid * 512 + tid; idx < 8 * 16 * 1024; idx += G * 512) { const int b = idx >> 14, g = (idx >> 10) & 15, k = idx & 1023;
                const float gs = pp->in[I_MIXN][1024 + k] * (1.0f + modF[(size_t)(8 + b) * 6144 + 1024 + k]);
                WGP[idx] = (bf16)(cvt_pk_bf16(gs * Win[(size_t)k * 3088 + 3072 + g], 0.f) & 0xffffu); }
            if (gw < 128) { const int b = gw >> 4, g = gw & 15; float a = 0.f;
                for (int k = lane; k < 1024; k += 64) a += modF[(size_t)(8 + b) * 6144 + k] * Win[(size_t)k * 3088 + 3072 + g];
                a = wave_sum(a); if (lane == 0) CGP[gw] = a; }
        }
        const float* x = pp->in[I_X];
        int bcur = -1; f32x4 gsv[4], shv[4];
        for (int m = gw; m < T; m += NGW) { const int b = m >> 12; const float* md = modF + (size_t)b * 6144;
            f32x4 v[4];
#pragma unroll
            for (int j = 0; j < 4; ++j) v[j] = __builtin_nontemporal_load((const f32x4*)(x + (size_t)m * 1024 + 4 * lane + 256 * j));
            if (b != bcur) { bcur = b;
#pragma unroll
                for (int j = 0; j < 4; ++j) { const int c = 4 * lane + 256 * j; gsv[j] = *(const f32x4*)(pp->in[I_MIXN] + c) * (*(const f32x4*)(md + 1024 + c) + 1.0f); shv[j] = *(const f32x4*)(md + c); } }
            float ss = 0.f;
#pragma unroll
            for (int j = 0; j < 4; ++j) ss += (v[j][0] * v[j][0] + v[j][1] * v[j][1]) + (v[j][2] * v[j][2] + v[j][3] * v[j][3]);
            const float rs = rsqrtf(wave_sum(ss) * (1.0f / 1024.0f) + RMS_EPS);
#pragma unroll
            for (int j = 0; j < 4; ++j) { const f32x4 o = v[j] * rs * gsv[j] + shv[j];
                int w = 0; w = __builtin_amdgcn_cvt_pk_fp8_f32(o[0], o[1], w, false); w = __builtin_amdgcn_cvt_pk_fp8_f32(o[2], o[3], w, true);
                *(int*)((unsigned char*)Hb + (size_t)m * 1024 + 4 * lane + 256 * j) = w; } }
    }
    GRID_BAR(); }

    for (int rep_ = 0; rep_ < REPS(2); ++rep_) {
    if (PH(2)) { PH_BEGIN
        pg8::DenseSched S; S.init(T, 3072, G, bid);
        EpiQKV<true> E{Qb, Kb, Vb, rope, pp->in[I_AQN], pp->in[I_AKN]};
        pg8::gemm_phase<EpiQKV<true>, pg8::DenseSched, true, true>(lds, Hb, Wqkv, S, E);
    }
    GRID_BAR(); }

    for (int rep_ = 0; rep_ < REPS(3); ++rep_) {
    if (PH(3)) { PH_BEGIN
        const int vcu = (G % 8 == 0) ? (bid % 8) * (G / 8) + bid / 8 : bid;
        const float lam = lamp[0];
        const f32x4 gA = *(const f32x4*)(pp->in[I_ASUB] + 8 * (lane & 15)) * 0.8f, gB = *(const f32x4*)(pp->in[I_ASUB] + 8 * (lane & 15) + 4) * 0.8f;
        for (int v2 = vcu; v2 < 256; v2 += G) {
            const int bh = v2 >> 2, c4 = v2 & 3;
            for (int i = 0; i < 8; ++i) { const int j = 4 * (i >> 1) + c4, qb = (i & 1) ? 31 - j : j;
                dattn::unit<8>(bh, qb, (const dattn::bf16h*)Qb, (const dattn::bf16h*)Kb, (const dattn::bf16h*)Vb, (dattn::bf16h*)ATTC, lam, gA, gB, (char*)lds_raw); }
        }
    }
    GRID_BAR(); }

    for (int layer = 0; layer < 2; ++layer) {
        if (layer == 1) {
            for (int rep_ = 0; rep_ < REPS(5); ++rep_) {
            if (PH(5)) { PH_BEGIN
                pg8::DenseSched S; S.init(T, 3072, G, bid);
                EpiMlIn<true> E{MQ, MK, MV, MO, IG, LF, pp->in[I_MBI], pp->in[I_MBF]};
                pg8::gemm_phase<EpiMlIn<true>, pg8::DenseSched, true, true>(lds, (const bf16*)Hb8L1, (const bf16*)Wml8, S, E);
                for (int tb = gw; tb < T / 16; tb += NGW) {
                    const int tk = lane & 15, kq = lane >> 4; const size_t tok = (size_t)tb * 16 + tk;
                    const int bq = (int)(tok >> 12);
                    const bf16* ar = X2 + tok * 1024 + 8 * kq; const bf16* br = WGP + (size_t)(bq * 16 + tk) * 1024 + 8 * kq;
                    f32x4 ga = {0.f, 0.f, 0.f, 0.f}; float ssq_ = 0.f;
#pragma unroll 8
                    for (int s_ = 0; s_ < 32; ++s_) { const v4u xw_ = *(const v4u*)(ar + 32 * s_);
                        ssq_ += (bf_lo(xw_.x) * bf_lo(xw_.x) + bf_hi(xw_.x) * bf_hi(xw_.x)) + (bf_lo(xw_.y) * bf_lo(xw_.y) + bf_hi(xw_.y) * bf_hi(xw_.y)) + (bf_lo(xw_.z) * bf_lo(xw_.z) + bf_hi(xw_.z) * bf_hi(xw_.z)) + (bf_lo(xw_.w) * bf_lo(xw_.w) + bf_hi(xw_.w) * bf_hi(xw_.w));
                        ga = __builtin_amdgcn_mfma_f32_16x16x32_bf16(__builtin_bit_cast(bf16x8, xw_), *(const bf16x8*)(br + 32 * s_), ga, 0, 0, 0); }
                    const float rs_tk = rsqrtf(sum_fq4(ssq_) * (1.0f / 1024.0f) + RMS_EPS);
                    const bool isf = tk >= 8; const float bb = (isf ? pp->in[I_MBF][tk - 8] : pp->in[I_MBI][tk]) + CGP[bq * 16 + tk]; float* dst = isf ? LF : IG;
#pragma unroll
                    for (int r = 0; r < 4; ++r) { float z = softcap15(ga[r] * __shfl(rs_tk, 4 * kq + r) + bb); if (isf) z = fminf(z, 0.f) - log1pf(__expf(-fabsf(z)));
                        dst[((size_t)tb * 16 + 4 * kq + r) * 8 + (tk & 7)] = z; }
                }
            }
            GRID_BAR(); }
            for (int rep_ = 0; rep_ < REPS(6); ++rep_) {
            if (PH(6)) { PH_BEGIN
                for (int u = bid; u < 256; u += G) { const int seg = u & 3; if (seg == 3) continue;
                    f32x16 CT; float gsum = 0.f, nreg = 0.f;
#pragma unroll
                    for (int r = 0; r < 16; ++r) CT[r] = 0.f;
                    mlstm_stream<false>(ldsp, ws, nullptr, u >> 5, (u >> 2) & 7, seg * 16, 16, tid, lane, wave, CT, gsum, nreg);
                    float* cts = (float*)(ws + WS_CTS) + (size_t)u * 8192;
#pragma unroll
                    for (int r = 0; r < 16; ++r) cts[(wave * 16 + r) * 64 + lane] = CT[r];
                    if (wave == 3) ((float*)(ws + WS_NS))[u * 64 + lane] = nreg;
                    if (tid == 0) ((float*)(ws + WS_GS))[u] = gsum;
                }
            }
            GRID_BAR(); }
            for (int rep_ = 0; rep_ < REPS(13); ++rep_) {
            if (PH(13)) { PH_BEGIN
                for (int u = bid; u < 256; u += G) { const int seg = u & 3;
                    f32x16 CT; float gsum = 0.f, nreg = 0.f;
#pragma unroll
                    for (int r = 0; r < 16; ++r) CT[r] = 0.f;
                    for (int sp = 0; sp < seg; ++sp) { const int up = (u & ~3) + sp; const float eg = __expf(((const float*)(ws + WS_GS))[up]);
                        const float* cts = (const float*)(ws + WS_CTS) + (size_t)up * 8192;
#pragma unroll
                        for (int r = 0; r < 16; ++r) CT[r] = CT[r] * eg + cts[(wave * 16 + r) * 64 + lane];
                        nreg = nreg * eg + ((const float*)(ws + WS_NS))[up * 64 + lane]; }
                    mlstm_stream<true>(ldsp, ws, pp->in[I_MON], u >> 5, (u >> 2) & 7, seg * 16, 16, tid, lane, wave, CT, gsum, nreg);
                }
            }
            GRID_BAR(); }
        }
        for (int rep_ = 0; rep_ < REPS(7); ++rep_) {
        if (PH(7)) { PH_BEGIN
            pg8::DenseSched S; S.init(T, 1024, G, bid);
            EpiResid E{pp->in[I_X], layer == 0 ? (const bf16*)nullptr : (const bf16*)X2, X1, mdL + 2048, (float*)(ws + WS_SSQ)};
            pg8::gemm_phase<EpiResid, pg8::DenseSched, true>(lds, ATTC, layer == 0 ? Wo : Wmlo, S, E);
        }
        GRID_BAR(); }
        if (PH(8)) { PH_BEGIN
            LAS unsigned char* rw = ldsp;
            LAS float* gsc = (LAS float*)(ldsp + LDSCTL_OFF + 4096); LAS float* shv = gsc + 1024;
            LAS float* lg = shv + 1024 + wave * (16 * 33);
            LAS int* hist = (LAS int*)(shv + 1024 + 8 * 16 * 33); LAS int* rec = hist + 32; LAS int* basee = rec + 512;
            const bf16* Whi = rwt + (size_t)layer * 32 * 1024; const bf16* Wlo = rwt + (size_t)(64 + layer * 32) * 1024;
            unsigned* gcnt = ctl + CW_CNT + layer * 32 * 16;
            for (int i = tid; i < 8192; i += 512) { const int r = i >> 7, c = i & 127;
                const v4u w = *(const v4u*)((r < 32 ? Whi + (size_t)r * 1024 : Wlo + (size_t)(r - 32) * 1024) + c * 8);
                *(LAS v4u*)(rw + r * 2048 + ((c ^ (r & 15)) << 4)) = w; }
            for (int blk = bid; blk < T / 128; blk += G) {
                const int b = blk >> 5; const float* md = mdL + (size_t)b * 6144;
                for (int i = tid; i < 1024; i += 512) { gsc[i] = pp->in[I_FFNN][layer * 1024 + i] * (1.0f + md[4 * 1024 + i]); shv[i] = md[3 * 1024 + i]; }
                if (tid < 32) hist[tid] = 0;
                __syncthreads();
                const int tk = lane & 15, kq = lane >> 4; const int tok = blk * 128 + wave * 16 + tk;
                const bf16* xr = X1 + (size_t)tok * 1024 + 8 * kq;
                float ss; { const f32x4 q4 = *(const f32x4*)((const float*)(ws + WS_SSQ) + (size_t)tok * 16 + 4 * kq); ss = (q4[0] + q4[1]) + (q4[2] + q4[3]); }
                ss = sum_fq4(ss);
                const float rs = rsqrtf(ss * (1.0f / 1024.0f) + RMS_EPS);
                f32x4 acc0 = {0.f, 0.f, 0.f, 0.f}, acc1 = {0.f, 0.f, 0.f, 0.f};
#pragma unroll 4
                for (int s = 0; s < 32; ++s) {
                    const int k0 = 32 * s + 8 * kq, sw = ((4 * s + kq) ^ tk) << 4;
                    const v4u xw = *(const v4u*)(xr + 32 * s);
                    const f32x4 a = {bf_lo(xw.x), bf_hi(xw.x), bf_lo(xw.y), bf_hi(xw.y)}, c = {bf_lo(xw.z), bf_hi(xw.z), bf_lo(xw.w), bf_hi(xw.w)};
                    const f32x4 g0 = *(const LAS f32x4*)(gsc + k0), g1 = *(const LAS f32x4*)(gsc + k0 + 4), h0 = *(const LAS f32x4*)(shv + k0), h1 = *(const LAS f32x4*)(shv + k0 + 4);
                    const f32x4 y0 = a * rs * g0 + h0, y1 = c * rs * g1 + h1;
                    v4u hw; hw.x = cvt_pk_bf16(y0[0], y0[1]); hw.y = cvt_pk_bf16(y0[2], y0[3]); hw.z = cvt_pk_bf16(y1[0], y1[1]); hw.w = cvt_pk_bf16(y1[2], y1[3]);
                    { const float y8[8] = {y0[0], y0[1], y0[2], y0[3], y1[0], y1[1], y1[2], y1[3]}; *(v2u*)((unsigned char*)Hb + (size_t)tok * 1024 + k0) = pack8_fp8(y8); }
                    v4u lw; lw.x = cvt_pk_bf16(y0[0] - bf_lo(hw.x), y0[1] - bf_hi(hw.x)); lw.y = cvt_pk_bf16(y0[2] - bf_lo(hw.y), y0[3] - bf_hi(hw.y));
                    lw.z = cvt_pk_bf16(y1[0] - bf_lo(hw.z), y1[1] - bf_hi(hw.z)); lw.w = cvt_pk_bf16(y1[2] - bf_lo(hw.w), y1[3] - bf_hi(hw.w));
                    const bf16x8 ah = __builtin_bit_cast(bf16x8, hw), al = __builtin_bit_cast(bf16x8, lw);
                    const bf16x8 wh0 = *(const LAS bf16x8*)(rw + tk * 2048 + sw), wh1 = *(const LAS bf16x8*)(rw + (16 + tk) * 2048 + sw);
                    const bf16x8 wl0 = *(const LAS bf16x8*)(rw + (32 + tk) * 2048 + sw), wl1 = *(const LAS bf16x8*)(rw + (48 + tk) * 2048 + sw);
                    acc0 = __builtin_amdgcn_mfma_f32_16x16x32_bf16(ah, wh0, acc0, 0, 0, 0); acc0 = __builtin_amdgcn_mfma_f32_16x16x32_bf16(al, wh0, acc0, 0, 0, 0); acc0 = __builtin_amdgcn_mfma_f32_16x16x32_bf16(ah, wl0, acc0, 0, 0, 0);
                    acc1 = __builtin_amdgcn_mfma_f32_16x16x32_bf16(ah, wh1, acc1, 0, 0, 0); acc1 = __builtin_amdgcn_mfma_f32_16x16x32_bf16(al, wh1, acc1, 0, 0, 0); acc1 = __builtin_amdgcn_mfma_f32_16x16x32_bf16(ah, wl1, acc1, 0, 0, 0);
                }
                { const float rb0 = pp->in[I_RB][layer * 32 + tk], rb1 = pp->in[I_RB][layer * 32 + 16 + tk];
#pragma unroll
                  for (int r = 0; r < 4; ++r) { lg[(4 * kq + r) * 33 + tk] = acc0[r] + rb0; lg[(4 * kq + r) * 33 + 16 + tk] = acc1[r] + rb1; } }
                LDS_WAIT(); asm volatile("" ::: "memory");
                if (lane < 16) {
                    const LAS float* row = lg + lane * 33; float tv[4]; int ti[4]; unsigned used = 0u;
#pragma unroll
                    for (int k = 0; k < 4; ++k) { float best = -INFINITY; int bi_ = 0;
                        for (int e = 0; e < 32; ++e) { const float v = row[e]; if (!((used >> e) & 1u) && v > best) { best = v; bi_ = e; } }
                        used |= 1u << bi_; tv[k] = best; ti[k] = bi_; }
                    float ex[4], sm = 0.f;
#pragma unroll
                    for (int k = 0; k < 4; ++k) { ex[k] = __expf(tv[k] - tv[0]); sm += ex[k]; }
                    const float inv = 1.0f / sm; const int tl = wave * 16 + lane, tg = blk * 128 + tl;
#pragma unroll
                    for (int k = 0; k < 4; ++k) { gatew[(size_t)tg * 4 + k] = ex[k] * inv; const int rk = atomicAdd((int*)&hist[ti[k]], 1); rec[tl * 4 + k] = (ti[k] << 16) | rk; }
                }
                __syncthreads();
                if (tid < 32) basee[tid] = (int)__hip_atomic_fetch_add(gcnt + tid * 16, (unsigned)hist[tid], RLX_AGENT);
                __syncthreads();
                { const int r = rec[tid], e = r >> 16, pos = basee[e] + (r & 0xffff), tg = blk * 128 + (tid >> 2), k = tid & 3;
                  list[(size_t)e * T + pos] = tg * 4 + k; toke[(size_t)tg * 4 + k] = e * T + pos; }
                __syncthreads();
            }
        }
        GRID_BAR();
        if (PH(9)) { PH_BEGIN
            if (tid < 32) Lcnt[tid] = (int)__hip_atomic_load(ctl + CW_CNT + (layer * 32 + tid) * 16, RLX_AGENT);
            __syncthreads();
            if (tid < 64) { const int v = tid < 32 ? (Lcnt[tid] + 255) >> 8 : 0; int inc = v;
#pragma unroll
                for (int o = 1; o < 32; o <<= 1) { const int t_ = __shfl_up(inc, o); if (lane >= o) inc += t_; }
                if (tid < 32) Ltstart[tid] = inc - v; if (tid == 31) Ltstart[32] = inc; }
            __syncthreads();
            for (int e = 0; e < 32; ++e) { const int t0 = Ltstart[e], t1 = Ltstart[e + 1]; for (int i = t0 + tid; i < t1; i += 512) Ltilee[i] = e; }
            __syncthreads();
        }
        if (PH(10)) {
#pragma nounroll
            for (int pass = 0; pass < 2; ++pass) { PH_BEGIN
                MoeSched<true> S{Lcnt, Ltstart, Ltilee, list, pass ? 4 : 8, pass ? 1024 : 2048, G, bid}; S.rtgather = pass ? 0 : 1;
                EpiMoe E{pass, EpiSwiglu{(unsigned char*)ACT, bgup + (size_t)layer * 32 * 2048}, EpiDown{(unsigned char*)Yb, pp->in[I_BDN] + (size_t)layer * 32 * 1024}};
                const bf16* Aop = pass ? (const bf16*)ACT : (const bf16*)Hb;
                const bf16* Bop = pass ? (const bf16*)((const unsigned char*)Wdn + (size_t)layer * 32 * 1024 * 1024) : (const bf16*)((const unsigned char*)Wgu + (size_t)layer * 32 * 2048 * 1024);
                pg8::gemm_phase<EpiMoe, MoeSched<true>, true, true>(lds, Aop, Bop, S, E);
                GRID_BAR();
            }
        }
        for (int rep_ = 0; rep_ < REPS(12); ++rep_) {
        if (PH(12)) { PH_BEGIN
            float* xo = pp->out;
            LAS float* g2v = (LAS float*)ldsp; LAS float* gsc1 = g2v + 1024; LAS float* sh1 = gsc1 + 1024;
            for (int blk = bid; blk < T / 128; blk += G) {
                const int b = blk >> 5; const float* md = mdL + (size_t)b * 6144; const float* md1 = modF + (size_t)(8 + b) * 6144;
                for (int i = tid; i < 1024; i += 512) { g2v[i] = md[5 * 1024 + i]; gsc1[i] = pp->in[I_MIXN][1024 + i] * (1.0f + md1[1024 + i]); sh1[i] = md1[i]; }
                __syncthreads();
                const int tok0 = blk * 128 + wave * 16;
                const int inf_l = toke[(size_t)tok0 * 4 + lane]; const float gk_l = gatew[(size_t)tok0 * 4 + lane];
                const int sl_l = Ltstart[inf_l >> 15] * 256 + (inf_l & (T - 1));
                f32x4 xa[4], xb[4]; unsigned ya[4][4], yb[4][4];
#define C_LOAD(q, X_, Y_) do { const int tok_ = tok0 + (q); \
                    _Pragma("unroll") for (int j = 0; j < 4; ++j) { const v2u xw_ = *(const v2u*)(X1 + (size_t)tok_ * 1024 + 4 * lane + 256 * j); X_[j] = (f32x4){bf_lo(xw_.x), bf_hi(xw_.x), bf_lo(xw_.y), bf_hi(xw_.y)}; } \
                    _Pragma("unroll") for (int k = 0; k < 4; ++k) { const int sk = __builtin_amdgcn_readlane(sl_l, 4 * (q) + k); \
                        _Pragma("unroll") for (int j = 0; j < 4; ++j) Y_[k][j] = __builtin_nontemporal_load((const unsigned*)((const unsigned char*)Yb + (size_t)sk * 1024 + 4 * lane + 256 * j)); } } while (0)
#define C_PROC(q, X_, Y_) do { const int tok_ = tok0 + (q); float gk[4]; \
                    _Pragma("unroll") for (int k = 0; k < 4; ++k) gk[k] = __int_as_float(__builtin_amdgcn_readlane(__float_as_int(gk_l), 4 * (q) + k)); \
                    f32x4 v[4]; float ss = 0.f; \
                    _Pragma("unroll") for (int j = 0; j < 4; ++j) { const int c = 4 * lane + 256 * j; f32x4 a = {0.f, 0.f, 0.f, 0.f}; \
                        _Pragma("unroll") for (int k = 0; k < 4; ++k) { const f32x2_c lo_ = __builtin_amdgcn_cvt_pk_f32_fp8((int)Y_[k][j], false), hi_ = __builtin_amdgcn_cvt_pk_f32_fp8((int)Y_[k][j], true); a[0] += gk[k] * lo_[0]; a[1] += gk[k] * lo_[1]; a[2] += gk[k] * hi_[0]; a[3] += gk[k] * hi_[1]; } \
                        v[j] = X_[j] + *(const LAS f32x4*)(g2v + c) * a; \
                        if (layer == 0) { v2u w_; w_.x = cvt_pk_bf16(v[j][0], v[j][1]); w_.y = cvt_pk_bf16(v[j][2], v[j][3]); *(v2u*)(X2 + (size_t)tok_ * 1024 + c) = w_; } else __builtin_nontemporal_store(v[j], (f32x4*)(xo + (size_t)tok_ * 1024 + c)); \
                        ss += (v[j][0] * v[j][0] + v[j][1] * v[j][1]) + (v[j][2] * v[j][2] + v[j][3] * v[j][3]); } \
                    if (layer == 0) { const float rs = rsqrtf(wave_sum(ss) * (1.0f / 1024.0f) + RMS_EPS); \
                        _Pragma("unroll") for (int j = 0; j < 4; ++j) { const int c = 4 * lane + 256 * j; const f32x4 o = v[j] * rs * *(const LAS f32x4*)(gsc1 + c) + *(const LAS f32x4*)(sh1 + c); \
                            int w8 = 0; w8 = __builtin_amdgcn_cvt_pk_fp8_f32(o[0], o[1], w8, false); w8 = __builtin_amdgcn_cvt_pk_fp8_f32(o[2], o[3], w8, true); *(int*)(Hb8L1 + (size_t)tok_ * 1024 + c) = w8; } } } while (0)
                C_LOAD(0, xa, ya);
                for (int q = 0; q < 16; q += 2) {
                    C_LOAD(q + 1, xb, yb);
                    C_PROC(q, xa, ya);
                    if (q + 2 < 16) C_LOAD(q + 2, xa, ya);
                    C_PROC(q + 1, xb, yb);
                }
#undef C_LOAD
#undef C_PROC
                __syncthreads();
            }
        }
        if (layer == 0 || rep_ + 1 < REPS(12)) GRID_BAR(); }
    }
#if defined(PROBE_GEMM)
    {
        GRID_BAR();
        PH_BEGIN
        const int layer = 1;
        MoeSched<false> S{Lcnt, Ltstart, Ltilee, list, 4, 1024, G, bid};
        EpiDown E{(unsigned char*)(ws + WS_Q), pp->in[I_BDN] + (size_t)layer * 32 * 1024};
        pg8::gemm_phase<EpiDown, MoeSched<false>, true, true, PROBE_GEMM>(lds, ACT, (const bf16*)((const unsigned char*)Wdn + (size_t)layer * 32 * 1024 * 1024), S, E);
    }
#endif
#if defined(PROBE_MFMA)
    {
        typedef int v8i_p __attribute__((ext_vector_type(8)));
        v8i_p a8, b8; bf16x8 a4, b4;
#pragma unroll
        for (int j = 0; j < 8; ++j) { a8[j] = 0x38383838 + (int)threadIdx.x; b8[j] = 0x3c3c3c3c - (int)threadIdx.x; a4[j] = (short)(0x3f80 + j); b4[j] = (short)(0x3f00 + j); }
        f32x4 pa[16];
#pragma unroll
        for (int j = 0; j < 16; ++j) pa[j] = (f32x4){0.f, 0.f, 0.f, 0.f};
#pragma nounroll
        for (int it = 0; it < 4000; ++it) {
#pragma unroll
            for (int j = 0; j < 16; ++j) {
#if PROBE_MFMA == 1
                pa[j] = __builtin_amdgcn_mfma_scale_f32_16x16x128_f8f6f4(a8, b8, pa[j], 0, 0, 0, 0x7f7f7f7f, 0, 0x7f7f7f7f);
#else
                pa[j] = __builtin_amdgcn_mfma_f32_16x16x32_bf16(a4, b4, pa[j], 0, 0, 0);
#endif
            }
            asm volatile("" : "+v"(a8), "+v"(b8), "+v"(a4), "+v"(b4));
        }
#pragma unroll
        for (int j = 0; j < 16; ++j) asm volatile("" :: "v"(pa[j]));
    }
#endif
}

extern "C" void kernel_launch(void* const* d_in, const int* in_sizes, int n_in, void* d_out, int out_size, void* d_ws, size_t ws_size, hipStream_t stream) {
    static int grid = 0;
    if (grid == 0) {
        if (n_in != 27 || out_size != T * DM || ws_size < WS_END) { fprintf(stderr, "kernel_launch: unexpected shapes (n_in %d out %d ws %zu)\n", n_in, out_size, ws_size); grid = -1; return; }
        int dev = 0, cus = 0, per_cu = 0;
        if (hipGetDevice(&dev) != hipSuccess || hipDeviceGetAttribute(&cus, hipDeviceAttributeMultiprocessorCount, dev) != hipSuccess) { grid = -1; return; }
        if (hipFuncSetAttribute((const void*)fwd, hipFuncAttributeMaxDynamicSharedMemorySize, LDS_BYTES) != hipSuccess) { fprintf(stderr, "kernel_launch: hipFuncSetAttribute failed\n"); grid = -1; return; }
        if (hipOccupancyMaxActiveBlocksPerMultiprocessor(&per_cu, (const void*)fwd, 512, LDS_BYTES) != hipSuccess || per_cu < 1) fprintf(stderr, "kernel_launch: occupancy query reports %d\n", per_cu);
        (void)hipGetLastError();
        grid = cus;
    }
    if (grid < 0) return;
    if (hipMemsetAsync((char*)d_ws + WS_CTL, 0, CTL_ZERO_BYTES, stream) != hipSuccess) return;
    Params p{};
    for (int i = 0; i < 27; ++i) p.in[i] = (const float*)d_in[i];
    p.out = (float*)d_out; p.ws = (unsigned char*)d_ws;
    for (int i = 0; i < 32; ++i) p.invf[i] = (float)std::pow(10000.0, -(double)(2 * i) / 64.0);
    hipLaunchKernelGGL(fwd, dim3(grid), dim3(512), LDS_BYTES, stream, p);
}
```
